# Optimizing an MI355X kernel written in HIP

```python
import jax, jax.numpy as jnp
from jax import lax
import numpy as np

D_MODEL = 2048
BATCH = 2
SEQ = 4096
DEPTH = 2

GRID_W = 64
CTX_LEN = 256
FOURIER_GROUPS = 4
FOURIER_GROUP_W = 128
FOURIER_W = FOURIER_GROUPS * FOURIER_GROUP_W
MLA_HEADS = 8
Q_RANK = 512
KV_RANK = 256
QK_NOPE = 128
QK_ROPE = 64
QK_HEAD = QK_NOPE + QK_ROPE
V_HEAD = 128
ROPE_THETA = 10000.0
AXIS_PAIRS = QK_ROPE // 4
Q_BLOCK = 128
CONV_W = 512
CONV_K = 3
N_BRANCH = 3
D_FF = ((8 * D_MODEL // 3 + 255) // 256) * 256
N_MOD = 6
RMS_EPS = 1e-6

OFF_F = 0
OFF_CQ = OFF_F + FOURIER_W
OFF_CKV = OFF_CQ + Q_RANK
OFF_KR = OFF_CKV + KV_RANK
OFF_CX = OFF_KR + QK_ROPE
OFF_CB = OFF_CX + CONV_W
OFF_CC = OFF_CB + CONV_W
OFF_G = OFF_CC + CONV_W
N_IN = OFF_G + N_BRANCH * D_MODEL

kernel_name = "hybrid_fourier_mla_shortconv_dit"


def rms_norm(x, gain):
    xf = x.astype(jnp.float32)
    y = xf * lax.rsqrt(jnp.mean(jnp.square(xf), axis=-1, keepdims=True) + RMS_EPS)
    return (y * gain.astype(jnp.float32)).astype(x.dtype)


def modulate(h, shift, scale):
    return h * (1.0 + scale) + shift


def axial_rope_tables(rows, dtype):
    row = jnp.repeat(jnp.arange(rows), GRID_W)
    col = jnp.tile(jnp.arange(GRID_W), rows)
    inv_freq = ROPE_THETA ** (-jnp.arange(AXIS_PAIRS, dtype=jnp.float32) / AXIS_PAIRS)
    ang = jnp.concatenate([row[:, None] * inv_freq, col[:, None] * inv_freq], axis=-1)
    return jnp.cos(ang)[:, None, :].astype(dtype), jnp.sin(ang)[:, None, :].astype(dtype)


def apply_rope(x, cos, sin):
    x1, x2 = x[..., : QK_ROPE // 2], x[..., QK_ROPE // 2:]
    return jnp.concatenate([x1 * cos - x2 * sin, x1 * sin + x2 * cos], axis=-1)


def rope_tail(x, rope):
    if rope is None:
        return x
    cos, sin = rope
    return jnp.concatenate([x[..., :QK_NOPE], apply_rope(x[..., QK_NOPE:], cos, sin)], axis=-1)


def mla_queries(p_cq, lw, rope):
    B, T, _ = p_cq.shape
    cq = rms_norm(p_cq, lw["q_a_norm"])
    q = (cq @ lw["w_uq"]).reshape(B, T, MLA_HEADS, QK_HEAD)
    q = rms_norm(q, lw["q_norm"])
    return rope_tail(q, rope)


def mla_keys_values(p_ckv, p_kr, lw, rope):
    B, T, _ = p_ckv.shape
    ckv = rms_norm(p_ckv, lw["kv_a_norm"])
    kv = (ckv @ lw["w_ukv"]).reshape(B, T, MLA_HEADS, QK_NOPE + V_HEAD)
    k_nope, v = kv[..., :QK_NOPE], kv[..., QK_NOPE:]
    k_rope = jnp.broadcast_to(p_kr[:, :, None, :], (B, T, MLA_HEADS, QK_ROPE))
    k = rms_norm(jnp.concatenate([k_nope, k_rope], axis=-1), lw["k_norm"])
    return rope_tail(k, rope), v


def attention(q, k, v):
    B, T, H, Dh = q.shape
    nb = T // Q_BLOCK
    scale = QK_HEAD ** -0.5
    qb = q.reshape(B, nb, Q_BLOCK, H, Dh).transpose(1, 0, 2, 3, 4)

    def one_block(q_blk):
        s = jnp.einsum("bqhd,bkhd->bhqk", q_blk, k).astype(jnp.float32) * scale
        pr = jax.nn.softmax(s, axis=-1).astype(v.dtype)
        return jnp.einsum("bhqk,bkhd->bqhd", pr, v)

    out = lax.map(one_block, qb)
    return out.transpose(1, 0, 2, 3, 4).reshape(B, T, H * V_HEAD)


def fourier_mix(pf):
    B, T, _ = pf.shape
    f = pf.astype(jnp.float32).reshape(B, T, FOURIER_GROUPS, FOURIER_GROUP_W)
    f = jnp.fft.fft2(f, axes=(1, 3), norm="ortho").real
    return f.reshape(B, T, FOURIER_W).astype(pf.dtype)


def short_conv_mix(px, pb, pc, conv_w):
    u = pc * px
    up = jnp.pad(u, ((0, 0), (1, 1), (0, 0)))
    y = up[:, :-2] * conv_w[0] + up[:, 1:-1] * conv_w[1] + up[:, 2:] * conv_w[2]
    return pb * y


def merge_branches(p, attn, lw):
    B, T, _ = p.shape
    y_f = fourier_mix(p[..., OFF_F:OFF_CQ]) @ lw["w_f_out"]
    y_m = attn @ lw["w_mla_out"]
    y_c = short_conv_mix(p[..., OFF_CX:OFF_CB], p[..., OFF_CB:OFF_CC], p[..., OFF_CC:OFF_G],
                         lw["conv_w"]) @ lw["w_conv_out"]
    g = jax.nn.sigmoid(p[..., OFF_G:] + lw["b_gate"]).reshape(B, T, N_BRANCH, D_MODEL)
    merged = g[..., 0, :] * y_f + g[..., 1, :] * y_m + g[..., 2, :] * y_c
    return merged @ lw["w_out"]


def latent_mixer(p, rope, k_ctx, v_ctx, lw):
    q = mla_queries(p[..., OFF_CQ:OFF_CKV], lw, rope)
    k, v = mla_keys_values(p[..., OFF_CKV:OFF_KR], p[..., OFF_KR:OFF_CX], lw, rope)
    attn = attention(q, jnp.concatenate([k_ctx, k], axis=1), jnp.concatenate([v_ctx, v], axis=1))
    return merge_branches(p, attn, lw)


def context_mixer(pc, k_ctx, v_ctx, lw):
    q = mla_queries(pc[..., OFF_CQ:OFF_CKV], lw, None)
    return merge_branches(pc, attention(q, k_ctx, v_ctx), lw)


def swiglu(h, lw):
    return (jax.nn.silu(h @ lw["w_ffn_gate"]) * (h @ lw["w_ffn_up"])) @ lw["w_ffn_down"]


def setup_inputs(seed: int = 0) -> dict:
    key = jax.random.key(seed)
    ks = jax.random.split(key, 24)
    L, D = DEPTH, D_MODEL

    def nrm(k, shape):
        return jax.random.normal(k, shape, jnp.float32)

    def w(k, shape, fan_in, gain=1.0):
        return (gain * fan_in ** -0.5) * nrm(k, shape)

    def g(k, shape):
        return 1.0 + 0.01 * nrm(k, shape)

    def b(k, shape):
        return 0.02 * nrm(k, shape)

    return {
        "x": nrm(ks[0], (BATCH, SEQ, D)),
        "c": nrm(ks[1], (BATCH, D)),
        "ctx": nrm(ks[2], (BATCH, CTX_LEN, D)),
        "c_ctx": nrm(ks[3], (D,)),
        "w_ada": w(ks[4], (L, D, N_MOD * D), D, 0.5),
        "b_ada": b(ks[5], (L, N_MOD * D)),
        "norm_mix": g(ks[6], (L, D)),
        "norm_ffn": g(ks[7], (L, D)),
        "w_in": w(ks[8], (L, D, N_IN), D),
        "b_gate": b(ks[9], (L, N_BRANCH * D)),
        "q_a_norm": g(ks[10], (L, Q_RANK)),
        "kv_a_norm": g(ks[11], (L, KV_RANK)),
        "w_uq": w(ks[12], (L, Q_RANK, MLA_HEADS * QK_HEAD), Q_RANK),
        "w_ukv": w(ks[13], (L, KV_RANK, MLA_HEADS * (QK_NOPE + V_HEAD)), KV_RANK),
        "q_norm": g(ks[14], (L, QK_HEAD)),
        "k_norm": g(ks[15], (L, QK_HEAD)),
        "w_f_out": w(ks[16], (L, FOURIER_W, D), FOURIER_W),
        "w_mla_out": w(ks[17], (L, MLA_HEADS * V_HEAD, D), MLA_HEADS * V_HEAD),
        "conv_w": w(ks[18], (L, CONV_K, CONV_W), CONV_K),
        "w_conv_out": w(ks[19], (L, CONV_W, D), CONV_W),
        "w_out": w(ks[20], (L, D, D), D),
        "w_ffn_gate": w(ks[21], (L, D, D_FF), D),
        "w_ffn_up": w(ks[22], (L, D, D_FF), D),
        "w_ffn_down": w(ks[23], (L, D_FF, D), D_FF),
    }


def reference(x, c, ctx, c_ctx, w_ada, b_ada, norm_mix, norm_ffn, w_in, b_gate,
              q_a_norm, kv_a_norm, w_uq, w_ukv, q_norm, k_norm,
              w_f_out, w_mla_out, conv_w, w_conv_out, w_out,
              w_ffn_gate, w_ffn_up, w_ffn_down):
    B, S, D = x.shape
    rows = S // GRID_W
    rope = axial_rope_tables(rows, x.dtype)
    ada_lat = jax.nn.silu(c)
    ada_ctx = jax.nn.silu(c_ctx)
    xc = ctx
    for l in range(DEPTH):
        last = l == DEPTH - 1
        lw = {
            "w_in": w_in[l], "b_gate": b_gate[l],
            "q_a_norm": q_a_norm[l], "kv_a_norm": kv_a_norm[l],
            "w_uq": w_uq[l], "w_ukv": w_ukv[l], "q_norm": q_norm[l], "k_norm": k_norm[l],
            "w_f_out": w_f_out[l], "w_mla_out": w_mla_out[l],
            "conv_w": conv_w[l], "w_conv_out": w_conv_out[l], "w_out": w_out[l],
            "w_ffn_gate": w_ffn_gate[l], "w_ffn_up": w_ffn_up[l], "w_ffn_down": w_ffn_down[l],
        }
        mod = (ada_lat @ w_ada[l] + b_ada[l]).reshape(B, N_MOD, 1, D)
        modc = (ada_ctx @ w_ada[l] + b_ada[l]).reshape(N_MOD, D)

        h = modulate(rms_norm(x, norm_mix[l]), mod[:, 0], mod[:, 1])
        hc = modulate(rms_norm(xc, norm_mix[l]), modc[0], modc[1])
        p = h @ lw["w_in"]
        if last:
            pc = hc @ lw["w_in"][:, OFF_CKV:OFF_CX]
            pc_ckv, pc_kr = pc[..., :KV_RANK], pc[..., KV_RANK:]
        else:
            pc = hc @ lw["w_in"]
            pc_ckv, pc_kr = pc[..., OFF_CKV:OFF_KR], pc[..., OFF_KR:OFF_CX]
        k_ctx, v_ctx = mla_keys_values(pc_ckv, pc_kr, lw, None)
        x = x + mod[:, 2] * latent_mixer(p, rope, k_ctx, v_ctx, lw)
        if not last:
            xc = xc + modc[2] * context_mixer(pc, k_ctx, v_ctx, lw)

        h2 = modulate(rms_norm(x, norm_ffn[l]), mod[:, 3], mod[:, 4])
        x = x + mod[:, 5] * swiglu(h2, lw)
        if not last:
            hc2 = modulate(rms_norm(xc, norm_ffn[l]), modc[3], modc[4])
            xc = xc + modc[5] * swiglu(hc2, lw)
    return x
```

```cpp
#include <hip/hip_runtime.h>
#include <hip/hip_cooperative_groups.h>
#include <cstdio>
#include <cstdint>
namespace cg = cooperative_groups;

#ifndef MK_MASK
#define MK_MASK 0xFFFF
#endif
#define PHON(b) if constexpr ((MK_MASK >> (b)) & 1)
#ifndef MK_PER_PHASE
#define MK_PER_PHASE 0
#endif

typedef unsigned short bf16_t;
typedef short bf16x8 __attribute__((ext_vector_type(8)));
typedef short s16x4 __attribute__((ext_vector_type(4)));
typedef float f32x2 __attribute__((ext_vector_type(2)));
typedef float f32x4 __attribute__((ext_vector_type(4)));
typedef float f32x16 __attribute__((ext_vector_type(16)));
typedef unsigned u32x2 __attribute__((ext_vector_type(2)));
typedef unsigned u32x4 __attribute__((ext_vector_type(4)));
#define LAS __attribute__((address_space(3)))

constexpr int DM = 2048, SEQ = 4096, NB = 2, CTXL = 256, ML = NB * SEQ  , MC = NB * CTXL  , MA = ML + MC  ;
constexpr int NIN = 9024, NINP = 9216, DFF = 5632, NH = 8, QKH = 192, VH = 128, TK = SEQ + CTXL  ;
constexpr int OFF_F = 0, OFF_CQ = 512, OFF_CKV = 1024, OFF_KR = 1280, OFF_CX = 1344, OFF_CB = 1856, OFF_CC = 2368, OFF_G = 2880;
constexpr float EPS = 1e-6f;

constexpr size_t al256(size_t x) { return (x + 255) / 256 * 256; }
constexpr size_t WS_MOD  = 0;
constexpr size_t WS_BAR  = al256(WS_MOD + (size_t)2 * 3 * 12288 * 4);
constexpr size_t WS_CNT  = WS_BAR + 256;
constexpr size_t WS_XBAR = WS_CNT + 1024;
constexpr size_t WS_ZERO_BYTES = WS_XBAR + 64 * 49 * 4;
constexpr size_t WS_WIN  = al256(WS_XBAR + 64 * 49 * 4);
constexpr size_t WS_WUQ  = WS_WIN + (size_t)NINP * DM * 2;
constexpr size_t WS_WUKV = WS_WUQ + (size_t)1536 * 512 * 2;
constexpr size_t WS_WMG  = WS_WUKV + (size_t)2048 * 256 * 2;
constexpr size_t WS_WOUT = WS_WMG + (size_t)2048 * 2048 * 2;
constexpr size_t WS_WGU  = WS_WOUT + (size_t)2048 * 2048 * 2;
constexpr size_t WS_WD   = WS_WGU + (size_t)2 * DFF * DM * 2;
constexpr size_t WS_BD   = WS_WD + (size_t)DM * DFF * 2;
constexpr size_t WS_VP   = WS_BD + (size_t)1024 * 512 * 2;
constexpr size_t WS_DB   = WS_VP + (size_t)64 * 1024 * 128 * 2;
constexpr size_t WS_DC   = WS_DB + (size_t)256 * 128 * 2;
constexpr size_t WS_TW   = WS_DC + (size_t)256 * 128 * 2;
constexpr size_t WS_A2C  = WS_TW + (size_t)64 * 64 * 2 * 4;
constexpr size_t WS_H    = WS_A2C + (size_t)256 * 512 * 2;
constexpr size_t WS_P    = WS_H + (size_t)MA * DM * 2;
constexpr size_t WS_ZQ   = WS_P + (size_t)MA * NINP * 2;
constexpr size_t WS_GT   = WS_ZQ + (size_t)MA * 1536 * 2;
constexpr size_t WS_GTC  = WS_GT + (size_t)1024 * 8192 * 2;
constexpr size_t WS_Q    = WS_GTC + (size_t)1024 * 512 * 2;
constexpr size_t WS_QC   = WS_Q + (size_t)NB * NH * SEQ * QKH * 2;
constexpr size_t WS_K    = WS_QC + (size_t)NB * NH * CTXL * QKH * 2;
constexpr size_t WS_V    = WS_K + (size_t)NB * NH * TK * QKH * 2;
constexpr size_t WS_ACAT = WS_V + (size_t)NB * NH * TK * VH * 2;
constexpr size_t WS_XA   = WS_ACAT + (size_t)MA * DM * 2;
constexpr size_t WS_BIAS = WS_XA + (size_t)MA * DM * 4;
constexpr size_t WS_ROPE = al256(WS_BIAS + (size_t)NINP * 4);
constexpr size_t WS_SLAB = WS_ROPE + (size_t)SEQ * 32 * 2 * 4;
constexpr size_t WS_END  = WS_SLAB + (size_t)11 * MC * DM * 4;

struct Params { const float* in[24]; float* out; unsigned char* ws; int ph_lo, ph_hi; };
enum { I_X = 0, I_C, I_CTX, I_CCTX, I_WADA, I_BADA, I_NMIX, I_NFFN, I_WIN, I_BGATE, I_QAN, I_KVAN, I_WUQ, I_WUKV, I_QN, I_KN,
       I_WF, I_WMLA, I_CONVW, I_WCONV, I_WOUT, I_WG, I_WU, I_WDN };

__device__ __forceinline__ int TID(int wv) { int t = (wv << 6) | (int)__builtin_amdgcn_mbcnt_hi(~0u, __builtin_amdgcn_mbcnt_lo(~0u, 0u)); asm volatile("" : "+v"(t)); return t; }
__device__ __forceinline__ int BID() { int t = blockIdx.x; asm volatile("" : "+s"(t)); return t; }
__device__ __forceinline__ int GDIM() { int t = gridDim.x; asm volatile("" : "+s"(t)); return t; }
__device__ __forceinline__ unsigned cvt_pk_bf16(float lo, float hi) { unsigned r; asm volatile("v_cvt_pk_bf16_f32 %0, %1, %2" : "=v"(r) : "v"(lo), "v"(hi)); return r; }
__device__ __forceinline__ float bf2f(bf16_t v) { return __uint_as_float(((unsigned)v) << 16); }
__device__ __forceinline__ float bflo(unsigned w) { return __uint_as_float(w << 16); }
__device__ __forceinline__ float bfhi(unsigned w) { return __uint_as_float(w & 0xffff0000u); }
__device__ __forceinline__ bf16_t f2bf(float f) { return (bf16_t)(cvt_pk_bf16(f, 0.f) & 0xffffu); }
__device__ __forceinline__ float wave_sum(float v) {
#pragma unroll
    for (int o = 32; o >= 1; o >>= 1) v += __shfl_xor(v, o);
    return v;
}
__device__ __forceinline__ float sigmoidf_(float z) { return __builtin_amdgcn_rcpf(1.0f + __expf(-z)); }

struct XBar { unsigned* w; unsigned xcc, nx, nxcc, uniform; };
__device__ __forceinline__ unsigned xb_xcc_id() { return (unsigned)__builtin_amdgcn_s_getreg((3 << 11) | 20) & 0xFu; }
__device__ __forceinline__ unsigned xb_ld(unsigned* p) { return __hip_atomic_load(p, __ATOMIC_RELAXED, __HIP_MEMORY_SCOPE_AGENT); }
__device__ __forceinline__ unsigned xbar_post(unsigned* w, int wv) {
    unsigned r = 0;
    if (wv == 0 && __builtin_amdgcn_mbcnt_hi(~0u, __builtin_amdgcn_mbcnt_lo(~0u, 0u)) == 0u) r = __hip_atomic_fetch_add(w + 64 * xb_xcc_id(), 1u, __ATOMIC_RELAXED, __HIP_MEMORY_SCOPE_AGENT);
    return r;
}
__device__ __forceinline__ XBar xbar_setup(unsigned* w) {
    XBar b; b.w = w; b.xcc = xb_xcc_id(); unsigned nx = 0, nxcc = 0, uni = 1;
    for (int j = 0; j < 16; ++j) { const unsigned cj = xb_ld(w + 64 * j); nxcc += cj ? 1u : 0u; if ((unsigned)j == b.xcc) nx = cj; uni &= (cj == (j < 8 ? 32u : 0u)) ? 1u : 0u; }
    b.uniform = (unsigned)__builtin_amdgcn_readfirstlane((int)uni);
    b.nx = (unsigned)__builtin_amdgcn_readfirstlane((int)nx); b.nxcc = (unsigned)__builtin_amdgcn_readfirstlane((int)nxcc); return b;
}
__device__ __forceinline__ void grid_barrier_first(unsigned* cnt, unsigned target, int wv) {
    asm volatile("s_waitcnt vmcnt(0)" ::: "memory");
    __syncthreads();
    if (wv == 0) {
        const int lane = (int)__builtin_amdgcn_mbcnt_hi(~0u, __builtin_amdgcn_mbcnt_lo(~0u, 0u));
        if (lane == 0) {
            __builtin_amdgcn_fence(__ATOMIC_RELEASE, "agent");
            asm volatile("s_waitcnt vmcnt(0)" ::: "memory");
            __hip_atomic_fetch_add(cnt, 1u, __ATOMIC_RELAXED, __HIP_MEMORY_SCOPE_AGENT);
            while (xb_ld(cnt) < target) __builtin_amdgcn_s_sleep(1);
            __builtin_amdgcn_fence(__ATOMIC_ACQUIRE, "agent");
            asm volatile("s_waitcnt vmcnt(0)" ::: "memory");
        }
    }
    __syncthreads();
}
__device__ __forceinline__ void grid_barrier(const XBar& b, unsigned k, int wv) {
    asm volatile("s_waitcnt vmcnt(0)" ::: "memory");
    __syncthreads();
    if (wv == 0) {
        const int lane = (int)__builtin_amdgcn_mbcnt_hi(~0u, __builtin_amdgcn_mbcnt_lo(~0u, 0u));
        if (lane == 0) {
            unsigned* xsub = b.w + 64 * (16 + b.xcc); unsigned* xgen = b.w + 64 * (32 + b.xcc); unsigned* top = b.w + 64 * 48;
            const unsigned old = __hip_atomic_fetch_add(xsub, 1u, __ATOMIC_RELAXED, __HIP_MEMORY_SCOPE_AGENT);
            if (old + 1u == k * b.nx) {
                __builtin_amdgcn_fence(__ATOMIC_RELEASE, "agent");
                asm volatile("s_waitcnt vmcnt(0)" ::: "memory");
                __hip_atomic_fetch_add(top, 1u, __ATOMIC_RELAXED, __HIP_MEMORY_SCOPE_AGENT);
            }
            (void)xgen;
            while (xb_ld(top) < k * b.nxcc) __builtin_amdgcn_s_sleep(1);
            __builtin_amdgcn_fence(__ATOMIC_ACQUIRE, "agent");
            asm volatile("s_waitcnt vmcnt(0)" ::: "memory");
        }
    }
    __syncthreads();
}

namespace g8 {
constexpr int BM = 256, BK = 64, HALF = 128, HTB = HALF * BK * 2, STAGE_BYTES = 8 * HTB, NXCD = 8, WGM = 8;
__device__ __forceinline__ int lds_byte(int r, int c) { const int st = (r >> 4) * 2 + (c >> 5), rr = r & 15, cc = c & 31, ob = rr * 64 + cc * 2; return st * 1024 + (ob ^ (((ob >> 9) & 1) << 5)); }
__device__ __forceinline__ void stage_rc(int b, int& R, int& C) { const int st = b / 1024, sb = b % 1024, swz = sb ^ (((sb >> 9) & 1) << 5); R = (st >> 1) * 16 + swz / 64; C = (st & 1) * 32 + (swz % 64) / 2; }
__device__ __forceinline__ int perm32(int rho) { const int n = rho >> 4, i = rho & 15; return 8 * (i >> 2) + 4 * n + (i & 3); }
struct Unit { int pm, pn, ks; };
struct Gemm { const bf16_t* A; const bf16_t* Bt; int lda, ldb, K; int kstepA = BK * 2, kstepB = BK * 2; };
struct Order {
    int nM, nN, nwg, G, c, eM0, eN0, eM, eN, eS, klen;
    __device__ void init(int nM_, int nN_, int G_, int c_, int eM0_ = 0, int eN0_ = 0, int eM_ = 0, int eN_ = 0, int eS_ = 0, int klen_ = 0) { nM = nM_; nN = nN_; nwg = nM * nN; G = G_; c = c_; eM0 = eM0_; eN0 = eN0_; eM = eM_; eN = eN_; eS = eS_; klen = klen_; }
    __device__ __forceinline__ bool next(int i, Unit& u) const {
        const int L = i * G + c;
        int pm = 0, pn = 0, ks = -1; bool ok = false;
        if (c >= 0) {
            if (L < nwg) {
                int wgid = L; { const int q = nwg / NXCD, r = nwg % NXCD, xcd = wgid % NXCD, off = wgid / NXCD; wgid = (xcd < r ? xcd * (q + 1) : r * (q + 1) + (xcd - r) * q) + off; }
                const int nig = WGM * nN, gid = wgid / nig, fm = gid * WGM, gsz = (nM - fm) < WGM ? (nM - fm) : WGM;
                pm = fm + ((wgid % nig) % gsz); pn = (wgid % nig) / gsz; ok = true;
            } else {
                const int Le = L - nwg, S1 = eS > 0 ? eS : 1;
                if (Le < eM * eN * S1) { const int ti = Le / S1; ks = eS > 0 ? Le % S1 : -1; pm = eM0 + ti % eM; pn = eN0 + ti / eM; ok = true; }
            }
        }
        u.pm = pm; u.pn = pn; u.ks = ks;
        return ok;
    }
};

template <class Epi, int BMODE = 0>
__device__ __forceinline__ void gemm_phase(LAS unsigned char* lds, const Gemm g, const Order& S, const Epi& E, int wv) {
    const int tid = TID(wv), wid = __builtin_amdgcn_readfirstlane(tid >> 6), lane = tid & 63, wr = wid >> 2, wc = wid & 3, fr = lane & 15, fq = lane >> 4;
    const int K = g.K, nt = K / BK;
    unsigned voffA, voffB;
    { int R, C; stage_rc(tid * 16, R, C); const int Rb = Epi::PERM ? ((R & ~31) + perm32(R & 31)) : R;
        const int rowB = BMODE == 0 ? Rb * g.ldb : (BMODE == 1 ? ((Rb >> 6) + 64 * (Rb & 63)) * g.ldb : (Rb >> 6) * 8192 + (Rb & 63) * 64);
        voffA = (unsigned)(R * g.lda + C) * 2u; voffB = (unsigned)(rowB + C) * 2u; }
    const size_t dA1 = (size_t)64 * g.lda * 2, dB1 = BMODE == 0 ? (size_t)64 * g.ldb * 2 : (BMODE == 1 ? (size_t)g.ldb * 2 : (size_t)8192 * 2);
    const size_t kstepA = (size_t)g.kstepA, kstepB = (size_t)g.kstepB;
    const size_t hstepA = (size_t)HALF * g.lda * 2, hstepB = BMODE == 0 ? (size_t)HALF * g.ldb * 2 : (BMODE == 1 ? (size_t)2 * g.ldb * 2 : (size_t)2 * 8192 * 2);
    const size_t tstepA = 2 * hstepA;
#define G8_BBASE(pn) ((const char*)g.Bt + (BMODE == 0 ? (size_t)(pn) * 2 * hstepB : (BMODE == 1 ? (size_t)((((pn) >> 4) * 4096) + ((pn) & 15) * 4) * g.ldb * 2 : (size_t)(pn) * 4 * 8192 * 2)))
    const unsigned ldsw = (unsigned)wid * 1024u;
    const int aoff = lds_byte(wr * 64 + fr, fq * 8), boff = lds_byte(wc * 32 + fr, fq * 8);
#define G8_SA(b, h) (((b) * 2 + (h)) * HTB)
#define G8_SB(b, h) ((4 + (b) * 2 + (h)) * HTB)
#define G8_STAGE(bufoff, gbase, voff) do { \
        __builtin_amdgcn_global_load_lds((const unsigned*)((const char*)(gbase) + (voff)), (LAS unsigned*)(lds + (bufoff) + ldsw), 16, 0, 0); \
        __builtin_amdgcn_global_load_lds((const unsigned*)((const char*)(gbase) + G8_D1(voff) + (voff)), (LAS unsigned*)(lds + (bufoff) + ldsw + 8192), 16, 0, 0); } while (0)
#define G8_D1(voff) (&(voff) == &voffA ? dA1 : dB1)
#define G8_LDA(dst, b, h) do { _Pragma("unroll") for (int m = 0; m < 4; ++m) _Pragma("unroll") for (int k = 0; k < 2; ++k) dst[m][k] = *(const LAS bf16x8*)(lds + G8_SA(b, h) + aoff + m * 2048 + k * 1024); } while (0)
#define G8_LDB(dst, b, h) do { _Pragma("unroll") for (int n = 0; n < 2; ++n) _Pragma("unroll") for (int k = 0; k < 2; ++k) dst[n][k] = *(const LAS bf16x8*)(lds + G8_SB(b, h) + boff + n * 2048 + k * 1024); } while (0)
#define G8_MMA(ai, bj, At, Bt) do { __builtin_amdgcn_s_setprio(1); _Pragma("unroll") for (int m = 0; m < 4; ++m) _Pragma("unroll") for (int n = 0; n < 2; ++n) _Pragma("unroll") for (int k = 0; k < 2; ++k) \
        acc[ai][bj][m][n] = __builtin_amdgcn_mfma_f32_16x16x32_bf16(Bt[n][k], At[m][k], acc[ai][bj][m][n], 0, 0, 0); __builtin_amdgcn_s_setprio(0); } while (0)
#define G8_WAIT_V(n) asm volatile("s_waitcnt vmcnt(" #n ")" ::: "memory")
#define G8_WAIT_L(n) asm volatile("s_waitcnt lgkmcnt(" #n ")" ::: "memory")
#define G8_BAR __builtin_amdgcn_s_barrier()
#define G8_SCHED __builtin_amdgcn_sched_barrier(0)
    Unit cur, nxt; int ui = 0;
    if (!S.next(0, cur)) return;
    f32x4 acc[2][2][4][2];
#pragma unroll
    for (int a = 0; a < 2; ++a)
#pragma unroll
        for (int b = 0; b < 2; ++b)
#pragma unroll
            for (int m = 0; m < 4; ++m)
#pragma unroll
                for (int n = 0; n < 2; ++n) acc[a][b][m][n] = (f32x4){0.f, 0.f, 0.f, 0.f};
    bf16x8 At[4][2], B0[2][2], B1[2][2];
#define G8_KOFF(u) ((u).ks >= 0 ? (size_t)(u).ks * S.klen * 2 : (size_t)0)
    const char* cA = (const char*)g.A + (size_t)cur.pm * tstepA + G8_KOFF(cur); const char* cB = G8_BBASE(cur.pn) + G8_KOFF(cur);
    G8_STAGE(G8_SB(0, 0), cB, voffB); G8_STAGE(G8_SA(0, 0), cA, voffA); G8_STAGE(G8_SB(0, 1), cB + hstepB, voffB); G8_STAGE(G8_SA(0, 1), cA + hstepA, voffA);
    if (wr == 1) G8_BAR;
    G8_WAIT_V(4); G8_BAR;
    G8_STAGE(G8_SB(1, 0), cB + kstepB, voffB); G8_STAGE(G8_SA(1, 0), cA + kstepA, voffA); G8_STAGE(G8_SB(1, 1), cB + hstepB + kstepB, voffB);
    G8_WAIT_V(6); G8_BAR;
    for (;;) {
        const bool has_next = S.next(ui + 1, nxt);
        const char* nA = has_next ? (const char*)g.A + (size_t)nxt.pm * tstepA + G8_KOFF(nxt) : cA; const char* nB = has_next ? G8_BBASE(nxt.pn) + G8_KOFF(nxt) : cB;
        const int ntu = cur.ks >= 0 ? S.klen / BK : nt;
        for (int t = 0; t < ntu; t += 2) {
            const bool last = (t == ntu - 2);
            const char* a1 = cA + (size_t)(t + 1) * kstepA;
            const char* a2 = last ? nA : cA + (size_t)(t + 2) * kstepA; const char* b2 = last ? nB : cB + (size_t)(t + 2) * kstepB;
            const char* a3 = a2 + kstepA; const char* b3 = b2 + kstepB;
            if constexpr (Epi::SEG) { if (t == Epi::SEG0 || t == Epi::SEG1) { const int t2 = TID(wv); E.seg(acc, cur, t, wr, wc, t2 & 15, (t2 >> 4) & 3); } }
            G8_LDB(B0, 0, 0); G8_SCHED; G8_LDA(At, 0, 0); G8_STAGE(G8_SA(1, 1), a1 + hstepA, voffA);
            G8_WAIT_L(8); G8_BAR; G8_WAIT_L(0); G8_MMA(0, 0, At, B0); G8_BAR; G8_SCHED;
            G8_LDB(B1, 0, 1); G8_STAGE(G8_SB(0, 0), b2, voffB);
            G8_BAR; G8_WAIT_L(0); G8_MMA(0, 1, At, B1); G8_BAR;
            G8_LDA(At, 0, 1); G8_STAGE(G8_SA(0, 0), a2, voffA);
            G8_BAR; G8_WAIT_L(0); G8_MMA(1, 0, At, B0); G8_BAR; G8_SCHED;
            G8_STAGE(G8_SB(0, 1), b2 + hstepB, voffB);
            G8_WAIT_V(6); G8_BAR; G8_MMA(1, 1, At, B1); G8_BAR;
            G8_LDB(B0, 1, 0); G8_SCHED; G8_LDA(At, 1, 0); G8_STAGE(G8_SA(0, 1), a2 + hstepA, voffA);
            G8_WAIT_L(8); G8_BAR; G8_WAIT_L(0); G8_MMA(0, 0, At, B0); G8_BAR; G8_SCHED;
            G8_LDB(B1, 1, 1); G8_STAGE(G8_SB(1, 0), b3, voffB);
            G8_BAR; G8_WAIT_L(0); G8_MMA(0, 1, At, B1); G8_BAR;
            G8_LDA(At, 1, 1); G8_STAGE(G8_SA(1, 0), a3, voffA);
            G8_BAR; G8_WAIT_L(0); G8_MMA(1, 0, At, B0); G8_BAR; G8_SCHED;
            G8_STAGE(G8_SB(1, 1), b3 + hstepB, voffB);
            G8_WAIT_V(6); G8_BAR; G8_MMA(1, 1, At, B1); G8_BAR;
        }
        { const int t2 = TID(wv); const int fr2 = t2 & 15, fq2 = (t2 >> 4) & 3; int wr2 = wr, wc2 = wc; asm volatile("" : "+s"(wr2), "+s"(wc2));
          E(acc, cur, wr2, wc2, fr2, fq2); }
        { int ui2 = ui + 1; asm volatile("" : "+s"(ui2)); if (!S.next(ui2, nxt)) break; }
#pragma unroll
        for (int a = 0; a < 2; ++a)
#pragma unroll
            for (int b = 0; b < 2; ++b)
#pragma unroll
                for (int m = 0; m < 4; ++m)
#pragma unroll
                    for (int n = 0; n < 2; ++n) acc[a][b][m][n] = (f32x4){0.f, 0.f, 0.f, 0.f};
        cur = nxt; cA = nA; cB = nB; ++ui;
    }
    G8_WAIT_V(0);
    if (wr == 0) G8_BAR;
    G8_BAR;
#undef G8_BBASE
#undef G8_KOFF
#undef G8_SA
#undef G8_SB
#undef G8_STAGE
#undef G8_D1
#undef G8_LDA
#undef G8_LDB
#undef G8_MMA
#undef G8_WAIT_V
#undef G8_WAIT_L
#undef G8_BAR
#undef G8_SCHED
}

struct EpiBf16 {
    static constexpr bool PERM = true, SEG = false; static constexpr int SEG0 = -1, SEG1 = -1;
    bf16_t* O; int ldc; int tps; size_t split_stride; int row_off; const float* bias;
    __device__ __forceinline__ void operator()(const f32x4 (&acc)[2][2][4][2], const Unit& u, int wr, int wc, int fr, int fq) const {
        const int row0 = row_off + u.pm * BM + wr * 64 + fr; bf16_t* base = O; int colt = u.pn * BM;
        if (tps) { const int t = u.pn / tps; base += (size_t)t * split_stride; colt = (u.pn - t * tps) * BM; }
        const int col0 = colt + wc * 32 + 8 * fq;
        f32x4 bv[2][2];
#pragma unroll
        for (int bj = 0; bj < 2; ++bj)
#pragma unroll
            for (int n = 0; n < 2; ++n) bv[bj][n] = bias ? *(const f32x4*)(bias + col0 + bj * HALF + 4 * n) : (f32x4){0.f, 0.f, 0.f, 0.f};
#pragma unroll
        for (int ai = 0; ai < 2; ++ai)
#pragma unroll
            for (int m = 0; m < 4; ++m) { bf16_t* rowp = base + (size_t)(row0 + ai * HALF + m * 16) * ldc + col0;
#pragma unroll
                for (int bj = 0; bj < 2; ++bj) { const f32x4 v0 = acc[ai][bj][m][0] + bv[bj][0], v1 = acc[ai][bj][m][1] + bv[bj][1];
                    u32x4 w; w.x = cvt_pk_bf16(v0[0], v0[1]); w.y = cvt_pk_bf16(v0[2], v0[3]); w.z = cvt_pk_bf16(v1[0], v1[1]); w.w = cvt_pk_bf16(v1[2], v1[3]);
                    *(u32x4*)(rowp + bj * HALF) = w; } }
    }
};
struct EpiF1 {
    static constexpr bool PERM = true, SEG = false; static constexpr int SEG0 = -1, SEG1 = -1;
    bf16_t* Gt; bf16_t* Gtc; int pn_off;
    __device__ __forceinline__ void operator()(const f32x4 (&acc)[2][2][4][2], const Unit& u, int wr, int wc, int fr, int fq) const {
        bf16_t* base; int T, b, t0;
        const int upn = u.pn + pn_off;
        if (upn < 32) { base = Gt; T = SEQ; b = upn >> 4; t0 = (upn & 15) * 256; } else { base = Gtc; T = CTXL; b = upn - 32; t0 = 0; }
        const int ld = 2 * T;
#pragma unroll
        for (int ai = 0; ai < 2; ++ai)
#pragma unroll
            for (int m = 0; m < 4; ++m) { bf16_t* rowp = base + (size_t)(b * 512 + u.pm * 128 + wr * 64 + m * 16 + fr) * ld + ai * T + t0 + wc * 32 + 8 * fq;
#pragma unroll
                for (int bj = 0; bj < 2; ++bj) { const f32x4 v0 = acc[ai][bj][m][0], v1 = acc[ai][bj][m][1];
                    u32x4 w; w.x = cvt_pk_bf16(v0[0], v0[1]); w.y = cvt_pk_bf16(v0[2], v0[3]); w.z = cvt_pk_bf16(v1[0], v1[1]); w.w = cvt_pk_bf16(v1[2], v1[3]);
                    *(u32x4*)(rowp + bj * HALF) = w; } }
    }
};
struct EpiTw {
    static constexpr bool PERM = true, SEG = false; static constexpr int SEG0 = -1, SEG1 = -1;
    bf16_t* V; const float* TW;
    __device__ __forceinline__ void operator()(const f32x4 (&acc)[2][2][4][2], const Unit& u, int wr, int wc, int fr, int fq) const {
        if (wr != 0) return;
#pragma unroll
        for (int mh = 0; mh < 2; ++mh) {
            f32x4 tw[2][2][4];
#pragma unroll
            for (int m2 = 0; m2 < 2; ++m2) { const int c = 16 * (2 * mh + m2) + fr;
#pragma unroll
                for (int bj = 0; bj < 2; ++bj) { const int r0 = u.pn * BM + bj * HALF + wc * 32 + 8 * fq, a0 = r0 & 63;
                    const f32x4* tp = (const f32x4*)(TW + (size_t)(c * 64 + a0) * 2);
                    tw[m2][bj][0] = tp[0]; tw[m2][bj][1] = tp[1]; tw[m2][bj][2] = tp[2]; tw[m2][bj][3] = tp[3]; } }
#pragma unroll
            for (int m2 = 0; m2 < 2; ++m2) { const int m = 2 * mh + m2, c = 16 * m + fr;
#pragma unroll
                for (int bj = 0; bj < 2; ++bj) { const int r0 = u.pn * BM + bj * HALF + wc * 32 + 8 * fq, nch = r0 >> 6, a0 = r0 & 63;
                    const f32x4 t0 = tw[m2][bj][0], t1 = tw[m2][bj][1], t2 = tw[m2][bj][2], t3 = tw[m2][bj][3];
                    const f32x4 ur0 = acc[0][bj][m][0], ur1 = acc[0][bj][m][1], ui0 = acc[1][bj][m][0], ui1 = acc[1][bj][m][1];
                    u32x4 w0, w1;
                    w0.x = cvt_pk_bf16(ur0[0] * t0[0] + ui0[0] * t0[1], ur0[1] * t0[2] + ui0[1] * t0[3]);
                    w0.y = cvt_pk_bf16(ur0[2] * t1[0] + ui0[2] * t1[1], ur0[3] * t1[2] + ui0[3] * t1[3]);
                    w0.z = cvt_pk_bf16(ur1[0] * t2[0] + ui1[0] * t2[1], ur1[1] * t2[2] + ui1[1] * t2[3]);
                    w0.w = cvt_pk_bf16(ur1[2] * t3[0] + ui1[2] * t3[1], ur1[3] * t3[2] + ui1[3] * t3[3]);
                    w1.x = cvt_pk_bf16(ui0[0] * t0[0] - ur0[0] * t0[1], ui0[1] * t0[2] - ur0[1] * t0[3]);
                    w1.y = cvt_pk_bf16(ui0[2] * t1[0] - ur0[2] * t1[1], ui0[3] * t1[2] - ur0[3] * t1[3]);
                    w1.z = cvt_pk_bf16(ui1[0] * t2[0] - ur1[0] * t2[1], ui1[1] * t2[2] - ur1[1] * t2[3]);
                    w1.w = cvt_pk_bf16(ui1[2] * t3[0] - ur1[2] * t3[1], ui1[3] * t3[2] - ur1[3] * t3[3]);
                    bf16_t* vp = V + ((size_t)(c * 1024 + nch) * 2) * 64 + a0;
                    *(u32x4*)vp = w0; *(u32x4*)(vp + 64) = w1; } }
            asm volatile("" ::: "memory"); }
    }
};
struct EpiFm2 {
    static constexpr bool PERM = true, SEG = false; static constexpr int SEG0 = -1, SEG1 = -1;
    bf16_t* O;
    __device__ __forceinline__ void operator()(const f32x4 (&acc)[2][2][4][2], const Unit& u, int wr, int wc, int fr, int fq) const {
        if (wr != 0) return;
        const int c = u.pn >> 2, q = u.pn & 3, bt = q >> 1, col0 = (q & 1) * 256 + wc * 32 + 8 * fq;
#pragma unroll
        for (int m = 0; m < 4; ++m) { const int d = 16 * m + fr; bf16_t* rowp = O + (size_t)(bt * SEQ + c + 64 * d) * DM + col0;
#pragma unroll
            for (int bj = 0; bj < 2; ++bj) { const f32x4 v0 = acc[0][bj][m][0], v1 = acc[0][bj][m][1];
                u32x4 w; w.x = cvt_pk_bf16(v0[0], v0[1]); w.y = cvt_pk_bf16(v0[2], v0[3]); w.z = cvt_pk_bf16(v1[0], v1[1]); w.w = cvt_pk_bf16(v1[2], v1[3]);
                *(u32x4*)(rowp + bj * HALF) = w; } }
    }
};
struct EpiMerge {
    static constexpr bool PERM = true, SEG = true; static constexpr int SEG0 = 8, SEG1 = 24;
    const bf16_t* P; bf16_t* O;
    float* slab; unsigned* cnt;
    __device__ __forceinline__ void seg(f32x4 (&acc)[2][2][4][2], const Unit& u, int t, int wr, int wc, int fr, int fq) const {
        const int gi = (t == SEG0) ? 0 : 1;
        const int col0 = u.pn * BM + wc * 32 + 8 * fq;
#pragma unroll
        for (int ai = 0; ai < 2; ++ai) {
            u32x4 za[4][2], zb[4][2];
#pragma unroll
            for (int m = 0; m < 4; ++m) { const bf16_t* prow = P + (size_t)(u.pm * BM + ai * HALF + wr * 64 + m * 16 + fr) * NINP + OFF_G + gi * DM + col0;
#pragma unroll
                for (int bj = 0; bj < 2; ++bj) { za[m][bj] = *(const u32x4*)(prow + bj * HALF); zb[m][bj] = *(const u32x4*)(prow + DM + bj * HALF); } }
#pragma unroll
            for (int m = 0; m < 4; ++m)
#pragma unroll
                for (int bj = 0; bj < 2; ++bj) { const u32x4 a = za[m][bj], b = zb[m][bj];
                    f32x4 r0, r1;
                    r0[0] = (1.f + __expf(-bflo(b.x))) * __builtin_amdgcn_rcpf(1.f + __expf(-bflo(a.x)));
                    r0[1] = (1.f + __expf(-bfhi(b.x))) * __builtin_amdgcn_rcpf(1.f + __expf(-bfhi(a.x)));
                    r0[2] = (1.f + __expf(-bflo(b.y))) * __builtin_amdgcn_rcpf(1.f + __expf(-bflo(a.y)));
                    r0[3] = (1.f + __expf(-bfhi(b.y))) * __builtin_amdgcn_rcpf(1.f + __expf(-bfhi(a.y)));
                    r1[0] = (1.f + __expf(-bflo(b.z))) * __builtin_amdgcn_rcpf(1.f + __expf(-bflo(a.z)));
                    r1[1] = (1.f + __expf(-bfhi(b.z))) * __builtin_amdgcn_rcpf(1.f + __expf(-bfhi(a.z)));
                    r1[2] = (1.f + __expf(-bflo(b.w))) * __builtin_amdgcn_rcpf(1.f + __expf(-bflo(a.w)));
                    r1[3] = (1.f + __expf(-bfhi(b.w))) * __builtin_amdgcn_rcpf(1.f + __expf(-bfhi(a.w)));
                    acc[ai][bj][m][0] *= r0; acc[ai][bj][m][1] *= r1; }
            asm volatile("" ::: "memory");
        }
    }
    __device__ __forceinline__ void operator()(const f32x4 (&acc)[2][2][4][2], const Unit& u, int wr, int wc, int fr, int fq) const {
        const int col0 = u.pn * BM + wc * 32 + 8 * fq;
        if (u.ks >= 0) {
            const int seg = (u.ks == 0) ? 0 : (u.ks == 3 ? 2 : 1);
#pragma unroll
            for (int ai = 0; ai < 2; ++ai) {
                u32x4 zz[4][2];
#pragma unroll
                for (int m = 0; m < 4; ++m) { const size_t row = (size_t)(u.pm * BM + ai * HALF + wr * 64 + m * 16 + fr);
#pragma unroll
                    for (int bj = 0; bj < 2; ++bj) zz[m][bj] = *(const u32x4*)(P + row * NINP + OFF_G + seg * DM + col0 + bj * HALF); }
#pragma unroll
                for (int m = 0; m < 4; ++m) { const size_t row = (size_t)(u.pm * BM + ai * HALF + wr * 64 + m * 16 + fr);
#pragma unroll
                    for (int bj = 0; bj < 2; ++bj) {
                        const int c = col0 + bj * HALF; const u32x4 z = zz[m][bj];
                        f32x4 v0 = acc[ai][bj][m][0], v1 = acc[ai][bj][m][1];
                        v0[0] *= sigmoidf_(bflo(z.x)); v0[1] *= sigmoidf_(bfhi(z.x)); v0[2] *= sigmoidf_(bflo(z.y)); v0[3] *= sigmoidf_(bfhi(z.y));
                        v1[0] *= sigmoidf_(bflo(z.z)); v1[1] *= sigmoidf_(bfhi(z.z)); v1[2] *= sigmoidf_(bflo(z.w)); v1[3] *= sigmoidf_(bfhi(z.w));
                        float* sp = slab + ((size_t)u.ks * MC + (row - ML)) * DM + c;
                        *(f32x4*)sp = v0; *(f32x4*)(sp + 4) = v1;
                    } }
                asm volatile("" ::: "memory");
            }
            asm volatile("s_waitcnt vmcnt(0)" ::: "memory");
            __builtin_amdgcn_fence(__ATOMIC_RELEASE, "agent");
            asm volatile("s_waitcnt vmcnt(0)" ::: "memory");
            unsigned old = 0;
            if (fr == 0 && fq == 0) old = __hip_atomic_fetch_add(cnt + ((u.pm - 32) * 8 + u.pn) * 8 + wr * 4 + wc, 1u, __ATOMIC_RELAXED, __HIP_MEMORY_SCOPE_AGENT);
            old = (unsigned)__builtin_amdgcn_readfirstlane((int)old);
            if (old == 3u) {
                __builtin_amdgcn_fence(__ATOMIC_ACQUIRE, "agent");
                asm volatile("s_waitcnt vmcnt(0)" ::: "memory");
#pragma unroll
                for (int ai = 0; ai < 2; ++ai)
#pragma unroll
                    for (int mh = 0; mh < 2; ++mh) {
                        f32x4 sv[2][2][4][2];
#pragma unroll
                        for (int m2 = 0; m2 < 2; ++m2) { const size_t row = (size_t)(u.pm * BM + ai * HALF + wr * 64 + (2 * mh + m2) * 16 + fr);
#pragma unroll
                            for (int bj = 0; bj < 2; ++bj) { const float* sp = slab + (size_t)(row - ML) * DM + col0 + bj * HALF;
#pragma unroll
                                for (int k2 = 0; k2 < 4; ++k2) { sv[m2][bj][k2][0] = *(const f32x4*)(sp + (size_t)k2 * MC * DM); sv[m2][bj][k2][1] = *(const f32x4*)(sp + (size_t)k2 * MC * DM + 4); } } }
#pragma unroll
                        for (int m2 = 0; m2 < 2; ++m2) { const size_t row = (size_t)(u.pm * BM + ai * HALF + wr * 64 + (2 * mh + m2) * 16 + fr);
#pragma unroll
                            for (int bj = 0; bj < 2; ++bj) {
                                const f32x4 v0 = (sv[m2][bj][0][0] + sv[m2][bj][1][0]) + (sv[m2][bj][2][0] + sv[m2][bj][3][0]), v1 = (sv[m2][bj][0][1] + sv[m2][bj][1][1]) + (sv[m2][bj][2][1] + sv[m2][bj][3][1]);
                                u32x4 w; w.x = cvt_pk_bf16(v0[0], v0[1]); w.y = cvt_pk_bf16(v0[2], v0[3]); w.z = cvt_pk_bf16(v1[0], v1[1]); w.w = cvt_pk_bf16(v1[2], v1[3]);
                                *(u32x4*)(O + row * DM + col0 + bj * HALF) = w; } }
                        asm volatile("" ::: "memory");
                    }
            }
            return;
        }
#pragma unroll
        for (int ai = 0; ai < 2; ++ai) {
            u32x4 zz[4][2];
#pragma unroll
            for (int m = 0; m < 4; ++m) { const size_t row = (size_t)(u.pm * BM + ai * HALF + wr * 64 + m * 16 + fr);
#pragma unroll
                for (int bj = 0; bj < 2; ++bj) zz[m][bj] = *(const u32x4*)(P + row * NINP + OFF_G + 2 * DM + col0 + bj * HALF); }
#pragma unroll
            for (int m = 0; m < 4; ++m) { const size_t row = (size_t)(u.pm * BM + ai * HALF + wr * 64 + m * 16 + fr);
#pragma unroll
                for (int bj = 0; bj < 2; ++bj) {
                    const int c = col0 + bj * HALF; const u32x4 z = zz[m][bj];
                    const f32x4 v0 = acc[ai][bj][m][0], v1 = acc[ai][bj][m][1];
                    u32x4 w;
                    w.x = cvt_pk_bf16(v0[0] * sigmoidf_(bflo(z.x)), v0[1] * sigmoidf_(bfhi(z.x)));
                    w.y = cvt_pk_bf16(v0[2] * sigmoidf_(bflo(z.y)), v0[3] * sigmoidf_(bfhi(z.y)));
                    w.z = cvt_pk_bf16(v1[0] * sigmoidf_(bflo(z.z)), v1[1] * sigmoidf_(bfhi(z.z)));
                    w.w = cvt_pk_bf16(v1[2] * sigmoidf_(bflo(z.w)), v1[3] * sigmoidf_(bfhi(z.w)));
                    *(u32x4*)(O + row * DM + c) = w;
                } }
            asm volatile("" ::: "memory");
        }
    }
};
template <bool RB, bool OB>
struct EpiResid {
    static constexpr bool PERM = true, SEG = false; static constexpr int SEG0 = -1, SEG1 = -1;
    const void* res_lat; const void* res_ctx; void* out_lat; void* out_ctx; const float* gate;
    float* slab;
    __device__ __forceinline__ void operator()(const f32x4 (&acc)[2][2][4][2], const Unit& u, int wr, int wc, int fr, int fq) const {
        if (u.ks >= 0) {
            float* sb = slab + ((size_t)u.ks * MC + (size_t)(u.pm - 32) * BM) * DM + u.pn * BM + wc * 32 + 8 * fq;
#pragma unroll
            for (int ai = 0; ai < 2; ++ai)
#pragma unroll
                for (int m = 0; m < 4; ++m) { float* rp = sb + (size_t)(ai * HALF + wr * 64 + m * 16 + fr) * DM;
#pragma unroll
                    for (int bj = 0; bj < 2; ++bj) { *(f32x4*)(rp + bj * HALF) = acc[ai][bj][m][0]; *(f32x4*)(rp + bj * HALF + 4) = acc[ai][bj][m][1]; } }
            return;
        }
        const int s = u.pm < 16 ? 0 : (u.pm < 32 ? 1 : 2);
        const size_t tile0 = (size_t)(u.pm < 32 ? u.pm : u.pm - 32) * BM * DM;
        const void* resv = u.pm < 32 ? res_lat : res_ctx; void* outv = u.pm < 32 ? out_lat : out_ctx;
        const int col0 = u.pn * BM + wc * 32 + 8 * fq;
        f32x4 gv[2][2];
#pragma unroll
        for (int bj = 0; bj < 2; ++bj)
#pragma unroll
            for (int n = 0; n < 2; ++n) gv[bj][n] = *(const f32x4*)(gate + s * 12288 + col0 + bj * HALF + 4 * n);
#pragma unroll
        for (int ai = 0; ai < 2; ++ai) {
            f32x4 r[4][2][2];
#pragma unroll
            for (int m = 0; m < 4; ++m) { const size_t off = tile0 + (size_t)(ai * HALF + wr * 64 + m * 16 + fr) * DM + col0;
#pragma unroll
                for (int bj = 0; bj < 2; ++bj) {
                    if constexpr (RB) { const u32x4 w = *(const u32x4*)((const bf16_t*)resv + off + bj * HALF);
                        r[m][bj][0] = (f32x4){bflo(w.x), bfhi(w.x), bflo(w.y), bfhi(w.y)}; r[m][bj][1] = (f32x4){bflo(w.z), bfhi(w.z), bflo(w.w), bfhi(w.w)}; }
                    else { r[m][bj][0] = *(const f32x4*)((const float*)resv + off + bj * HALF); r[m][bj][1] = *(const f32x4*)((const float*)resv + off + bj * HALF + 4); } } }
#pragma unroll
            for (int m = 0; m < 4; ++m) { const size_t off = tile0 + (size_t)(ai * HALF + wr * 64 + m * 16 + fr) * DM + col0;
#pragma unroll
                for (int bj = 0; bj < 2; ++bj) { const f32x4 v0 = r[m][bj][0] + gv[bj][0] * acc[ai][bj][m][0], v1 = r[m][bj][1] + gv[bj][1] * acc[ai][bj][m][1];
                    if constexpr (OB) { u32x4 w; w.x = cvt_pk_bf16(v0[0], v0[1]); w.y = cvt_pk_bf16(v0[2], v0[3]); w.z = cvt_pk_bf16(v1[0], v1[1]); w.w = cvt_pk_bf16(v1[2], v1[3]);
                        *(u32x4*)((bf16_t*)outv + off + bj * HALF) = w; }
                    else { *(f32x4*)((float*)outv + off + bj * HALF) = v0; *(f32x4*)((float*)outv + off + bj * HALF + 4) = v1; } } }
            asm volatile("" ::: "memory"); }
    }
};
struct EpiSwiglu {
    static constexpr bool PERM = true, SEG = false; static constexpr int SEG0 = -1, SEG1 = -1;
    bf16_t* T;
    __device__ __forceinline__ void operator()(const f32x4 (&acc)[2][2][4][2], const Unit& u, int wr, int wc, int fr, int fq) const {
        const int col0 = u.pn * HALF + wc * 32 + 8 * fq;
#pragma unroll
        for (int ai = 0; ai < 2; ++ai)
#pragma unroll
            for (int m = 0; m < 4; ++m) { bf16_t* rowp = T + (size_t)(u.pm * BM + ai * HALF + wr * 64 + m * 16 + fr) * DFF + col0;
                f32x4 o0, o1;
#pragma unroll
                for (int j = 0; j < 4; ++j) { const float g0 = acc[ai][0][m][0][j], g1 = acc[ai][0][m][1][j];
                    o0[j] = g0 * sigmoidf_(g0) * acc[ai][1][m][0][j]; o1[j] = g1 * sigmoidf_(g1) * acc[ai][1][m][1][j]; }
                u32x4 w; w.x = cvt_pk_bf16(o0[0], o0[1]); w.y = cvt_pk_bf16(o0[2], o0[3]); w.z = cvt_pk_bf16(o1[0], o1[1]); w.w = cvt_pk_bf16(o1[2], o1[3]);
                *(u32x4*)rowp = w; }
    }
};
}

namespace at {
constexpr int DQ = 192, DV = 128, NW = 8, QBLK = 32, KVBLK = 64;
constexpr float SCALE = 0.07216878364870322f;
constexpr float THR = 8.f;
#ifndef QKT_GRP
#define QKT_GRP 12
#endif
constexpr size_t SHM_V = KVBLK * DV * 2, SHM_K = KVBLK * DQ * 2, SHM_ATTN = 2 * SHM_V + 2 * SHM_K + NW * 64 * 4;
#define KSWZ(row, colB) ((row) * 384 + ((colB) ^ ((((row) >> 1) & 7) << 4)))
#define SBAR() __builtin_amdgcn_sched_barrier(0)
__device__ __forceinline__ int crow(int r, int hi) { return (r & 3) + 8 * (r >> 2) + 4 * hi; }
__device__ __forceinline__ void partialSM(f32x16& p0, f32x16& p1, float& m_reg, float& mn, float& alpha) {
    constexpr float C = SCALE * 1.4426950408889634f;
    float pmax = p0[0];
#pragma unroll
    for (int r = 1; r < 16; ++r) pmax = fmaxf(pmax, p0[r]);
#pragma unroll
    for (int r = 0; r < 16; ++r) pmax = fmaxf(pmax, p1[r]);
    { auto rr = __builtin_amdgcn_permlane32_swap(__float_as_uint(pmax), __float_as_uint(pmax), false, false);
      pmax = fmaxf(__uint_as_float(rr[0]), __uint_as_float(rr[1])); }
    if (__builtin_expect(__all(pmax - m_reg <= THR / SCALE), 1)) { mn = m_reg; alpha = 1.f; }
    else { mn = fmaxf(m_reg, pmax); alpha = __builtin_amdgcn_exp2f((m_reg - mn) * C); m_reg = mn; }
    const float mnC = -mn * C;
#pragma unroll
    for (int r = 0; r < 16; ++r) p0[r] = fmaf(p0[r], C, mnC);
#pragma unroll
    for (int r = 0; r < 16; ++r) p1[r] = fmaf(p1[r], C, mnC);
#pragma unroll
    for (int r = 0; r < 16; ++r) p0[r] = __builtin_amdgcn_exp2f(p0[r]);
}
__device__ __forceinline__ void finishSM(f32x16& p0, f32x16& p1, float alpha, float& l_reg, bf16x8& pa0, bf16x8& pa1, bf16x8& pa2, bf16x8& pa3) {
#pragma unroll
    for (int r = 0; r < 16; ++r) p1[r] = __builtin_amdgcn_exp2f(p1[r]);
    float ps = 0;
#pragma unroll
    for (int r = 0; r < 16; ++r) ps += p0[r];
#pragma unroll
    for (int r = 0; r < 16; ++r) ps += p1[r];
    { auto rr = __builtin_amdgcn_permlane32_swap(__float_as_uint(ps), __float_as_uint(ps), false, false);
      ps = __uint_as_float(rr[0]) + __uint_as_float(rr[1]); }
    l_reg = l_reg * alpha + ps;
#define PK4(P, BASE, OUT) do { unsigned a0 = cvt_pk_bf16(P[BASE + 0], P[BASE + 1]), a1 = cvt_pk_bf16(P[BASE + 2], P[BASE + 3]);   \
    unsigned b0 = cvt_pk_bf16(P[BASE + 4], P[BASE + 5]), b1 = cvt_pk_bf16(P[BASE + 6], P[BASE + 7]);                              \
    auto r0 = __builtin_amdgcn_permlane32_swap(a0, b0, false, false); auto r1 = __builtin_amdgcn_permlane32_swap(a1, b1, false, false); \
    u32x4 w = {r0[0], r1[0], r0[1], r1[1]}; OUT = *reinterpret_cast<bf16x8*>(&w); } while (0)
    PK4(p0, 0, pa0); PK4(p0, 8, pa1); PK4(p1, 0, pa2); PK4(p1, 8, pa3);
#undef PK4
}
__device__ __forceinline__ void qkt(f32x16& p0, f32x16& p1, const char* Ks, const bf16x8* qr, int wv) {
    p0 = f32x16{}; p1 = f32x16{};
    const int l_ = TID(wv) & 63, r32 = l_ & 31, hi = l_ >> 5;
    const int sw = ((r32 >> 1) & 7) << 4, rb = r32 * 384;
    const char* kb[4];
#pragma unroll
    for (int i = 0; i < 4; ++i) kb[i] = Ks + rb + ((i * 32 + hi * 16) ^ sw);
#pragma unroll
    for (int d0 = 0; d0 < 12; ++d0) {
        const bf16x8 b0 = *reinterpret_cast<const bf16x8*>(kb[d0 & 3] + (d0 >> 2) * 128);
        const bf16x8 b1 = *reinterpret_cast<const bf16x8*>(kb[d0 & 3] + (d0 >> 2) * 128 + 32 * 384);
        p0 = __builtin_amdgcn_mfma_f32_32x32x16_bf16(b0, qr[d0], p0, 0, 0, 0);
        p1 = __builtin_amdgcn_mfma_f32_32x32x16_bf16(b1, qr[d0], p1, 0, 0, 0); }
}
__device__ __forceinline__ int v_st(int k, int c) { const int kk = (k & ~0xC) | ((k & 4) << 1) | ((k & 8) >> 1); return ((kk >> 3) * 4 + (c >> 5)) * 512 + ((kk & 7) * 32 + (c & 31)) * 2; }
__device__ __forceinline__ int v_rd_base(int lane) { return ((lane & 3) << 3) | (((lane >> 2) & 3) << 6) | (((lane >> 4) & 1) << 5) | (((lane >> 5) & 1) << 8); }
constexpr int v_rd_off(int d0, int ks, int half) { return d0 * 512 + ks * 4096 + half * 2048; }
template <int OFF> __device__ __forceinline__ s16x4 tr_read(int vb) {
    s16x4 r; asm volatile("ds_read_b64_tr_b16 %0, %1 offset:%2" : "=&v"(r) : "v"(vb), "i"(OFF) : "memory"); return r;
}
template <int D0> __device__ __forceinline__ void pv_one(f32x16& od, int vb, bf16x8 pa0, bf16x8 pa1, bf16x8 pa2, bf16x8 pa3) {
    const s16x4 l0 = tr_read<v_rd_off(D0, 0, 0)>(vb), h0 = tr_read<v_rd_off(D0, 0, 1)>(vb), l1 = tr_read<v_rd_off(D0, 1, 0)>(vb), h1 = tr_read<v_rd_off(D0, 1, 1)>(vb);
    const s16x4 l2 = tr_read<v_rd_off(D0, 2, 0)>(vb), h2 = tr_read<v_rd_off(D0, 2, 1)>(vb), l3 = tr_read<v_rd_off(D0, 3, 0)>(vb), h3 = tr_read<v_rd_off(D0, 3, 1)>(vb);
    asm volatile("s_waitcnt lgkmcnt(0)" ::: "memory"); SBAR();
#define PK(L, H) (bf16x8){L[0], L[1], L[2], L[3], H[0], H[1], H[2], H[3]}
    od = __builtin_amdgcn_mfma_f32_32x32x16_bf16(pa0, PK(l0, h0), od, 0, 0, 0);
    od = __builtin_amdgcn_mfma_f32_32x32x16_bf16(pa1, PK(l1, h1), od, 0, 0, 0);
    od = __builtin_amdgcn_mfma_f32_32x32x16_bf16(pa2, PK(l2, h2), od, 0, 0, 0);
    od = __builtin_amdgcn_mfma_f32_32x32x16_bf16(pa3, PK(l3, h3), od, 0, 0, 0);
#undef PK
}
__device__ __forceinline__ void pv_d0(f32x16* o, int vb, bf16x8 pa0, bf16x8 pa1, bf16x8 pa2, bf16x8 pa3) {
    pv_one<0>(o[0], vb, pa0, pa1, pa2, pa3); pv_one<1>(o[1], vb, pa0, pa1, pa2, pa3); pv_one<2>(o[2], vb, pa0, pa1, pa2, pa3); pv_one<3>(o[3], vb, pa0, pa1, pa2, pa3);
}
constexpr size_t SHM_ATTN2 = 3 * SHM_V + 2 * SHM_K + NW * 64 * 4;
__device__ __forceinline__ void attn_body(const bf16_t* __restrict__ Qb, const bf16_t* __restrict__ Kh, const bf16_t* __restrict__ Vh,
                                          bf16_t* __restrict__ Ob, int ldo, int seq, char* lds, int wv) {
    const int tid = TID(wv), wid = tid >> 6, lane = tid & 63, r32 = lane & 31, hi = lane >> 5;
    char* V_lds = lds; char* K_lds = lds + 3 * SHM_V;
    float* wsf = (float*)(lds + 3 * SHM_V + 2 * SHM_K) + wid * 64; float* li_l = wsf; float* al_l = wsf + 32;
    LAS unsigned char* ldsl = (LAS unsigned char*)(unsigned)(uintptr_t)lds;
    float m_reg = -1e30f, l_reg = 0; f32x16 o[4] = {}; bf16x8 qr[12];
    const bf16_t* Qw = Qb + (long)(wid * QBLK + r32) * DQ + hi * 8;
#pragma unroll
    for (int d0 = 0; d0 < 12; ++d0) qr[d0] = *reinterpret_cast<const bf16x8*>(Qw + d0 * 16);
    const int vbase = (int)(uintptr_t)V_lds;
#define vb0 (vbase + v_rd_base(TID(wv) & 63))
    const unsigned ldsw = (unsigned)__builtin_amdgcn_readfirstlane(wid) * 1024u;
#define KSRC(t_, i) ({ const int _q = (i) * 512 + (t_), _row = _q / 24, _cb = (_q - _row * 24) * 16; (unsigned)(_row * 384 + (_cb ^ (((_row >> 1) & 7) << 4))); })
#define VSRC(t_, i) ({ const int _ob = ((i) * 512 + (t_)) * 16, _sub = _ob >> 9, _w = _ob & 511, _kk = (_sub >> 2) * 8 + (_w >> 6), _c = (_sub & 3) * 32 + ((_w >> 1) & 31); \
    const int _k = (_kk & ~0xC) | ((_kk & 4) << 1) | ((_kk & 8) >> 1); (unsigned)(_k * 256 + _c * 2); })
#define GLDS_TILE(t, kb, vbuf) do { const int t_ = TID(wv); const char* _kp = (const char*)Kh + (size_t)(t) * (KVBLK * DQ * 2); const char* _vp = (const char*)Vh + (size_t)(t) * (KVBLK * DV * 2); \
    _Pragma("unroll") for (int _i = 0; _i < 3; ++_i) __builtin_amdgcn_global_load_lds((const unsigned*)(_kp + KSRC(t_, _i)), (LAS unsigned*)(ldsl + 3 * SHM_V + (kb) * SHM_K + _i * 8192 + ldsw), 16, 0, 0); \
    _Pragma("unroll") for (int _i = 0; _i < 2; ++_i) __builtin_amdgcn_global_load_lds((const unsigned*)(_vp + VSRC(t_, _i)), (LAS unsigned*)(ldsl + (vbuf) + _i * 8192 + ldsw), 16, 0, 0); } while (0)
#define TSYNC() do { asm volatile("s_waitcnt vmcnt(0)" ::: "memory"); __syncthreads(); } while (0)
#define RESC(a) do { if (__any((a) < 1.f)) { if (hi == 0) al_l[r32] = (a); asm volatile("s_waitcnt lgkmcnt(0)" ::: "memory"); \
    _Pragma("unroll") for (int d = 0; d < 4; ++d) _Pragma("unroll") for (int r = 0; r < 16; ++r) o[d][r] *= al_l[crow(r, hi)]; } } while (0)
    f32x16 pA0, pA1, pB0, pB1; float mnA, mnB, alA, alB; bf16x8 pa0, pa1, pa2, pa3; const int NT = seq / KVBLK;
    GLDS_TILE(0, 0, 0); TSYNC();
    GLDS_TILE(1, 1, (int)SHM_V);
    qkt(pA0, pA1, K_lds, qr, wv); partialSM(pA0, pA1, m_reg, mnA, alA);
    TSYNC();
    int vprev = 0, vcur = (int)SHM_V, vnext = 2 * (int)SHM_V;
    for (int j = 1; j + 1 < NT; j += 2) {
        GLDS_TILE(j + 1, 0, vnext);
        SBAR(); qkt(pB0, pB1, K_lds + SHM_K, qr, wv);
        finishSM(pA0, pA1, alA, l_reg, pa0, pa1, pa2, pa3); SBAR();
        pv_d0(o, vb0 + vprev, pa0, pa1, pa2, pa3); partialSM(pB0, pB1, m_reg, mnB, alB);
        TSYNC(); RESC(alB);
        GLDS_TILE(j + 2, 1, vprev);
        SBAR(); qkt(pA0, pA1, K_lds, qr, wv);
        finishSM(pB0, pB1, alB, l_reg, pa0, pa1, pa2, pa3); SBAR();
        pv_d0(o, vb0 + vcur, pa0, pa1, pa2, pa3); partialSM(pA0, pA1, m_reg, mnA, alA);
        TSYNC(); RESC(alA);
        { const int t0 = vprev; vprev = vnext; vnext = vcur; vcur = t0; }
    }
    SBAR(); qkt(pB0, pB1, K_lds + SHM_K, qr, wv);
    finishSM(pA0, pA1, alA, l_reg, pa0, pa1, pa2, pa3); SBAR();
    pv_d0(o, vb0 + vprev, pa0, pa1, pa2, pa3); partialSM(pB0, pB1, m_reg, mnB, alB);
    RESC(alB);
    finishSM(pB0, pB1, alB, l_reg, pa0, pa1, pa2, pa3); SBAR();
    pv_d0(o, vb0 + vcur, pa0, pa1, pa2, pa3);
    if (hi == 0) li_l[r32] = l_reg; asm volatile("s_waitcnt lgkmcnt(0)" ::: "memory");
    float rli[16];
#pragma unroll
    for (int r = 0; r < 16; ++r) rli[r] = __builtin_amdgcn_rcpf(li_l[crow(r, hi)]);
    bf16_t* Ow = Ob + (long)(wid * QBLK) * ldo;
#pragma unroll
    for (int r = 0; r < 16; ++r) { const int orow = crow(r, hi);
#pragma unroll
        for (int d0 = 0; d0 < 4; ++d0) Ow[(long)orow * ldo + d0 * 32 + r32] = f2bf(o[d0][r] * rli[r]); }
#undef vb0
#undef GLDS_TILE
#undef KSRC
#undef VSRC
#undef TSYNC
#undef RESC
}
}

constexpr int NT_ = 512;

__device__ void adaln_phase(const Params& P, int wv) {
    float* mod = (float*)(P.ws + WS_MOD);
    const float* c = P.in[I_C]; const float* cc = P.in[I_CCTX];
    const int tid = TID(wv), lane = tid & 63, kk = lane >> 2, c4 = lane & 3;
    const int gwv = BID() * 8 + (tid >> 6), nwv = GDIM() * 8;
    for (int item = gwv; item < 2 * 768; item += nwv) {
        const int l = item / 768, col = (item % 768) * 16 + c4 * 4;
        const float* W = P.in[I_WADA] + (size_t)l * DM * 12288 + col;
        f32x4 a0 = {0, 0, 0, 0}, a1 = a0, a2 = a0;
#pragma unroll 8
        for (int i = 0; i < 128; ++i) {
            const int k = kk + 16 * i;
            const f32x4 w = *(const f32x4*)(W + (size_t)k * 12288);
            float x0 = c[k], x1 = c[DM + k], x2 = cc[k];
            x0 = x0 * sigmoidf_(x0); x1 = x1 * sigmoidf_(x1); x2 = x2 * sigmoidf_(x2);
            a0 += x0 * w; a1 += x1 * w; a2 += x2 * w;
        }
#pragma unroll
        for (int o = 4; o <= 32; o <<= 1)
#pragma unroll
            for (int j = 0; j < 4; ++j) { a0[j] += __shfl_xor(a0[j], o); a1[j] += __shfl_xor(a1[j], o); a2[j] += __shfl_xor(a2[j], o); }
        if (kk == 0) {
            const f32x4 bsv = *(const f32x4*)(P.in[I_BADA] + l * 12288 + col);
            float* m0 = mod + (size_t)(l * 3) * 12288 + col;
            *(f32x4*)m0 = a0 + bsv; *(f32x4*)(m0 + 12288) = a1 + bsv; *(f32x4*)(m0 + 2 * 12288) = a2 + bsv;
        }
    }
}

__device__ void dft_phase(const Params& P, int wv) {
    bf16_t* Bd = (bf16_t*)(P.ws + WS_BD); bf16_t* A2c = (bf16_t*)(P.ws + WS_A2C);
    const int gt = BID() * NT_ + TID(wv), gs = GDIM() * NT_;
    for (int id = gt; id < 1024 * 64; id += gs) {
        const int m = id >> 6, k0 = (id & 63) * 8, g = m >> 8, ri = (m >> 7) & 1, cidx = m & 127;
        float v[8];
#pragma unroll
        for (int e = 0; e < 8; ++e) { const int k = k0 + e, g2 = k >> 7, c2 = k & 127; const float fr = (float)((cidx * c2) & 127) * (1.0f / 128.0f);
            const float t = ri ? -__builtin_amdgcn_sinf(fr) : __builtin_amdgcn_cosf(fr); v[e] = (g2 == g) ? t * 0.08838834764831845f : 0.f; }
        u32x4 w = {cvt_pk_bf16(v[0], v[1]), cvt_pk_bf16(v[2], v[3]), cvt_pk_bf16(v[4], v[5]), cvt_pk_bf16(v[6], v[7])};
        *(u32x4*)(Bd + (size_t)m * 512 + k0) = w;
    }
    { float* RT = (float*)(P.ws + WS_ROPE);
      for (int id = gt; id < SEQ * 32; id += gs) { const int t = id >> 5, i = id & 31; const float invf = __builtin_amdgcn_exp2f(-(float)(i & 15) * (13.287712379549449f / 16.0f));
        const float ang = (float)((i < 16) ? (t >> 6) : (t & 63)) * invf, rev = ang * 0.15915494309189535f, fr = rev - floorf(rev);
        RT[id * 2] = __builtin_amdgcn_cosf(fr); RT[id * 2 + 1] = __builtin_amdgcn_sinf(fr); } }
    { float* TW = (float*)(P.ws + WS_TW);
      for (int id = gt; id < 64 * 64; id += gs) { const int c = id >> 6, a = id & 63; const float ph = (float)(c * a) * (1.0f / 4096.0f);
        TW[id * 2] = __builtin_amdgcn_cosf(ph); TW[id * 2 + 1] = __builtin_amdgcn_sinf(ph); } }
    { bf16_t* DB = (bf16_t*)(P.ws + WS_DB); bf16_t* DC = (bf16_t*)(P.ws + WS_DC);
      for (int id = gt; id < 2 * 256 * 16; id += gs) {
        const int which = id >> 12, m = (id >> 4) & 255, k0 = (id & 15) * 8;
        float v[8];
#pragma unroll
        for (int e = 0; e < 8; ++e) { const int k = k0 + e, ri = k >> 6, x = k & 63; float val;
            if (which == 0) { const int ro = m >> 7, c = m & 127; const float ph = (float)((c * x) & 63) * (1.0f / 64.0f); const float cs = __builtin_amdgcn_cosf(ph), sn = __builtin_amdgcn_sinf(ph);
                val = (c < 64) ? (ro == ri ? cs : (ro == 0 ? sn : -sn)) : 0.f; }
            else { const float ph = (float)((m * x) & 63) * (1.0f / 64.0f); val = (m < 64) ? (ri ? __builtin_amdgcn_sinf(ph) : __builtin_amdgcn_cosf(ph)) * (1.0f / 64.0f) : 0.f; }
            v[e] = val; }
        u32x4 w = {cvt_pk_bf16(v[0], v[1]), cvt_pk_bf16(v[2], v[3]), cvt_pk_bf16(v[4], v[5]), cvt_pk_bf16(v[6], v[7])};
        *(u32x4*)((which ? DC : DB) + (size_t)m * 128 + k0) = w; } }
    for (int id = gt; id < 256 * 64; id += gs) {
        const int t = id >> 6, k0 = (id & 63) * 8, ri = k0 >> 8;
        float v[8];
#pragma unroll
        for (int e = 0; e < 8; ++e) { const int tp = (k0 + e) & 255; const float fr = (float)((t * tp) & 255) * (1.0f / 256.0f);
            v[e] = (ri ? __builtin_amdgcn_sinf(fr) : __builtin_amdgcn_cosf(fr)) * (1.0f / 16.0f); }
        u32x4 w = {cvt_pk_bf16(v[0], v[1]), cvt_pk_bf16(v[2], v[3]), cvt_pk_bf16(v[4], v[5]), cvt_pk_bf16(v[6], v[7])};
        *(u32x4*)(A2c + (size_t)t * 512 + k0) = w;
    }
}

struct WJob { const float* src; bf16_t* dst; const float* scale; int K, N, ldd, koff, nmode; };
__device__ __forceinline__ WJob get_wjob(int mi, const Params& P, int l) {
    WJob j; j.scale = nullptr; j.koff = 0; j.nmode = 0;
    unsigned char* ws = P.ws;
    switch (mi) {
    case 0: j.src = P.in[I_WIN] + (size_t)l * DM * NIN; j.dst = (bf16_t*)(ws + WS_WIN); j.K = DM; j.N = NIN; j.ldd = DM; break;
    case 1: j.src = P.in[I_WUQ] + (size_t)l * 512 * 1536; j.dst = (bf16_t*)(ws + WS_WUQ); j.K = 512; j.N = 1536; j.ldd = 512; j.scale = P.in[I_QAN] + l * 512; break;
    case 2: j.src = P.in[I_WUKV] + (size_t)l * 256 * 2048; j.dst = (bf16_t*)(ws + WS_WUKV); j.K = 256; j.N = 2048; j.ldd = 256; j.scale = P.in[I_KVAN] + l * 256; break;
    case 3: j.src = P.in[I_WF] + (size_t)l * 512 * DM; j.dst = (bf16_t*)(ws + WS_WMG); j.K = 512; j.N = DM; j.ldd = DM; j.koff = 0; break;
    case 4: j.src = P.in[I_WMLA] + (size_t)l * 1024 * DM; j.dst = (bf16_t*)(ws + WS_WMG); j.K = 1024; j.N = DM; j.ldd = DM; j.koff = 512; break;
    case 5: j.src = P.in[I_WCONV] + (size_t)l * 512 * DM; j.dst = (bf16_t*)(ws + WS_WMG); j.K = 512; j.N = DM; j.ldd = DM; j.koff = 1536; break;
    case 6: j.src = P.in[I_WOUT] + (size_t)l * DM * DM; j.dst = (bf16_t*)(ws + WS_WOUT); j.K = DM; j.N = DM; j.ldd = DM; break;
    case 7: j.src = P.in[I_WG] + (size_t)l * DM * DFF; j.dst = (bf16_t*)(ws + WS_WGU); j.K = DM; j.N = DFF; j.ldd = DM; j.nmode = 1; break;
    case 8: j.src = P.in[I_WU] + (size_t)l * DM * DFF; j.dst = (bf16_t*)(ws + WS_WGU); j.K = DM; j.N = DFF; j.ldd = DM; j.nmode = 2; break;
    default: j.src = P.in[I_WDN] + (size_t)l * DFF * DM; j.dst = (bf16_t*)(ws + WS_WD); j.K = DFF; j.N = DM; j.ldd = DFF; break;
    }
    return j;
}
__device__ void wprep_phase(const Params& P, int l, unsigned char* lds_generic, int wv) {
    float* tile = (float*)lds_generic;
    const int tid = TID(wv), G = GDIM(), bid = BID();
    int base = 0;
#pragma unroll
    for (int mi = 0; mi < 10; ++mi) {
        const WJob j = get_wjob(mi, P, l);
        const int nkt = j.K / 64, nnt = j.N / 64, ngn = (nnt + 3) / 4, ngroups = nkt * ngn;
        int start = (bid - base % G + G) % G;
#define WLOAD(dst, grp_) do { const int _kt = (grp_) / ngn, _ng = (grp_) % ngn, _k0 = _kt * 64; \
            _Pragma("unroll") for (int q = 0; q < 4; ++q) { const int ntile = _ng * 4 + q; const bool ok = ntile < nnt; \
                _Pragma("unroll") for (int i = 0; i < 2; ++i) { const int kr = (tid >> 4) + 32 * i; dst[q][i] = ok ? *(const f32x4*)(j.src + (size_t)(_k0 + kr) * j.N + ntile * 64 + (tid & 15) * 4) : (f32x4){0, 0, 0, 0}; } } } while (0)
        f32x4 vn[4][2];
        if (start < ngroups) WLOAD(vn, start);
        for (int grp = start; grp < ngroups; grp += G) {
            const int kt = grp / ngn, ng = grp % ngn, k0 = kt * 64;
            f32x4 v[4][2];
#pragma unroll
            for (int q = 0; q < 4; ++q) { v[q][0] = vn[q][0]; v[q][1] = vn[q][1]; }
            if (grp + G < ngroups) WLOAD(vn, grp + G);
            __syncthreads();
#pragma unroll
            for (int q = 0; q < 4; ++q)
#pragma unroll
                for (int i = 0; i < 2; ++i) { const int kr = (tid >> 4) + 32 * i; float* tp = tile + (q * 64 + kr) * 65 + (tid & 15) * 4;
                    tp[0] = v[q][i][0]; tp[1] = v[q][i][1]; tp[2] = v[q][i][2]; tp[3] = v[q][i][3]; }
            __syncthreads();
            const int nl = tid >> 3, kc = (tid & 7) * 8;
            float sc[8];
#pragma unroll
            for (int e = 0; e < 8; ++e) sc[e] = j.scale ? j.scale[k0 + kc + e] : 1.f;
#pragma unroll
            for (int q = 0; q < 4; ++q) { const int ntile = ng * 4 + q; if (ntile < nnt) {
                float x[8];
#pragma unroll
                for (int e = 0; e < 8; ++e) x[e] = tile[(q * 64 + kc + e) * 65 + nl] * sc[e];
                const int n = ntile * 64 + nl;
                const int nd = j.nmode == 0 ? n : ((n >> 7) * 256 + (n & 127) + (j.nmode == 2 ? 128 : 0));
                u32x4 w = {cvt_pk_bf16(x[0], x[1]), cvt_pk_bf16(x[2], x[3]), cvt_pk_bf16(x[4], x[5]), cvt_pk_bf16(x[6], x[7])};
                *(u32x4*)(j.dst + (size_t)nd * j.ldd + j.koff + k0 + kc) = w; } }
        }
#undef WLOAD
        base += ngroups;
    }
    __syncthreads();
    { float* bp = (float*)(P.ws + WS_BIAS); const float* bgt = P.in[I_BGATE] + l * 3 * DM;
      for (int id = bid * NT_ + tid; id < NINP; id += G * NT_) bp[id] = (id >= OFF_G && id < NIN) ? bgt[id - OFF_G] : 0.f; }
    { bf16_t* W = (bf16_t*)(P.ws + WS_WIN) + (size_t)NIN * DM; const int n16 = (NINP - NIN) * DM / 8;
      for (int id = bid * NT_ + tid; id < n16; id += G * NT_) *(u32x4*)(W + (size_t)id * 8) = (u32x4){0, 0, 0, 0}; }
}

template <bool LB, bool CB>
__device__ __forceinline__ void norm_phase(const void* src_lat, const void* src_ctx, int nrows, const float* gain, const float* mod, int jshift, bf16_t* h, int wv,
                           const float* slab = nullptr, int nsplit = 0, const float* sgate = nullptr, bf16_t* xout = nullptr) {
    const int tid = TID(wv), lane = tid & 63, gw = BID() * 8 + (tid >> 6), nw = GDIM() * 8;
    u32x4 rb[4]; f32x4 rf[4][2];
#define NP_ROWMAP(r0) ((slab != nullptr) ? ((r0) + MC < nrows ? (r0) + MC : (r0) + MC - nrows + ML - (nrows - MC)) : (r0))
#define NP_LOAD(row_) do { \
        if ((row_) < ML) { _Pragma("unroll") for (int i = 0; i < 4; ++i) { const int col = (lane + 64 * i) * 8; \
            if constexpr (LB) rb[i] = *(const u32x4*)((const bf16_t*)src_lat + (size_t)(row_) * DM + col); \
            else { const float* xr = (const float*)src_lat + (size_t)(row_) * DM; rf[i][0] = *(const f32x4*)(xr + col); rf[i][1] = *(const f32x4*)(xr + col + 4); } } } \
        else { _Pragma("unroll") for (int i = 0; i < 4; ++i) { const int col = (lane + 64 * i) * 8; \
            if constexpr (CB) rb[i] = *(const u32x4*)((const bf16_t*)src_ctx + (size_t)((row_) - ML) * DM + col); \
            else { const float* xr = (const float*)src_ctx + (size_t)((row_) - ML) * DM; rf[i][0] = *(const f32x4*)(xr + col); rf[i][1] = *(const f32x4*)(xr + col + 4); } } } } while (0)
    int row0 = gw;
    if (row0 >= nrows) return;
    int rown = NP_ROWMAP(row0);
    NP_LOAD(rown);
    for (;;) {
        const int row = rown;
        const int s = row < SEQ ? 0 : (row < ML ? 1 : 2);
        f32x4 v[4][2]; float ss = 0.f;
        const bool isb = (row < ML) ? LB : CB;
#pragma unroll
        for (int i = 0; i < 4; ++i) {
            if (isb) { const u32x4 w = rb[i]; v[i][0] = (f32x4){bflo(w.x), bfhi(w.x), bflo(w.y), bfhi(w.y)}; v[i][1] = (f32x4){bflo(w.z), bfhi(w.z), bflo(w.w), bfhi(w.w)}; }
            else { v[i][0] = rf[i][0]; v[i][1] = rf[i][1]; } }
        const int nrow0 = row0 + nw; const bool more = nrow0 < nrows;
        if (more) { rown = NP_ROWMAP(nrow0); NP_LOAD(rown); }
        if (slab != nullptr && row >= ML) {
            f32x4 a[4][2];
#pragma unroll
            for (int i = 0; i < 4; ++i) { a[i][0] = (f32x4){0.f, 0.f, 0.f, 0.f}; a[i][1] = a[i][0]; }
#pragma unroll 4
            for (int ks = 0; ks < nsplit; ++ks) { const float* sp = slab + ((size_t)ks * MC + (row - ML)) * DM;
#pragma unroll
                for (int i = 0; i < 4; ++i) { const int col = (lane + 64 * i) * 8; a[i][0] += *(const f32x4*)(sp + col); a[i][1] += *(const f32x4*)(sp + col + 4); } }
#pragma unroll
            for (int i = 0; i < 4; ++i) { const int col = (lane + 64 * i) * 8;
                v[i][0] += *(const f32x4*)(sgate + col) * a[i][0]; v[i][1] += *(const f32x4*)(sgate + col + 4) * a[i][1];
                u32x4 w = {cvt_pk_bf16(v[i][0][0], v[i][0][1]), cvt_pk_bf16(v[i][0][2], v[i][0][3]), cvt_pk_bf16(v[i][1][0], v[i][1][1]), cvt_pk_bf16(v[i][1][2], v[i][1][3])};
                *(u32x4*)(xout + (size_t)(row - ML) * DM + col) = w;
                v[i][0] = (f32x4){bflo(w.x), bfhi(w.x), bflo(w.y), bfhi(w.y)}; v[i][1] = (f32x4){bflo(w.z), bfhi(w.z), bflo(w.w), bfhi(w.w)}; }
        }
#pragma unroll
        for (int i = 0; i < 4; ++i)
#pragma unroll
            for (int e = 0; e < 4; ++e) ss += v[i][0][e] * v[i][0][e] + v[i][1][e] * v[i][1][e];
        ss = wave_sum(ss);
        const float r = 1.0f / sqrtf(ss * (1.0f / DM) + EPS);
        const float* sh = mod + s * 12288 + jshift * DM; const float* scl = sh + DM;
#pragma unroll
        for (int i = 0; i < 4; ++i) { const int col = (lane + 64 * i) * 8; float y[8];
#pragma unroll
            for (int hh = 0; hh < 2; ++hh) { const f32x4 g = *(const f32x4*)(gain + col + 4 * hh), a = *(const f32x4*)(scl + col + 4 * hh), b = *(const f32x4*)(sh + col + 4 * hh);
#pragma unroll
                for (int e = 0; e < 4; ++e) y[4 * hh + e] = (v[i][hh][e] * r * g[e]) * (1.0f + a[e]) + b[e]; }
            u32x4 w = {cvt_pk_bf16(y[0], y[1]), cvt_pk_bf16(y[2], y[3]), cvt_pk_bf16(y[4], y[5]), cvt_pk_bf16(y[6], y[7])};
            *(u32x4*)(h + (size_t)row * DM + col) = w; }
        if (!more) break;
        row0 = nrow0;
    }
#undef NP_ROWMAP
#undef NP_LOAD
}

__device__ void conv_phase(const bf16_t* p, const float* cw  , bf16_t* acat, int ntok, int wv) {
    const int gt_ = BID() * NT_ + TID(wv), gs_ = GDIM() * NT_;
    for (int id = gt_; id < ntok * 64; id += gs_) {
        const int tok = id >> 6, ch = (id & 63) * 8;
        int t, T; if (tok < ML) { t = tok & (SEQ - 1); T = SEQ; } else { t = (tok - ML) & (CTXL - 1); T = CTXL; }
        const bf16_t* pr = p + (size_t)tok * NINP;
        float y[8];
#pragma unroll
        for (int e = 0; e < 8; ++e) y[e] = 0.f;
#pragma unroll
        for (int d = -1; d <= 1; ++d) {
            if (t + d < 0 || t + d >= T) continue;
            const u32x4 xx = *(const u32x4*)(pr + (long)d * NINP + OFF_CX + ch), cc = *(const u32x4*)(pr + (long)d * NINP + OFF_CC + ch);
            const f32x4 w0 = *(const f32x4*)(cw + (d + 1) * 512 + ch), w1 = *(const f32x4*)(cw + (d + 1) * 512 + ch + 4);
            y[0] += w0[0] * bflo(xx.x) * bflo(cc.x); y[1] += w0[1] * bfhi(xx.x) * bfhi(cc.x);
            y[2] += w0[2] * bflo(xx.y) * bflo(cc.y); y[3] += w0[3] * bfhi(xx.y) * bfhi(cc.y);
            y[4] += w1[0] * bflo(xx.z) * bflo(cc.z); y[5] += w1[1] * bfhi(xx.z) * bfhi(cc.z);
            y[6] += w1[2] * bflo(xx.w) * bflo(cc.w); y[7] += w1[3] * bfhi(xx.w) * bfhi(cc.w);
        }
        const u32x4 bb = *(const u32x4*)(pr + OFF_CB + ch);
        u32x4 w = {cvt_pk_bf16(y[0] * bflo(bb.x), y[1] * bfhi(bb.x)), cvt_pk_bf16(y[2] * bflo(bb.y), y[3] * bfhi(bb.y)),
                   cvt_pk_bf16(y[4] * bflo(bb.z), y[5] * bfhi(bb.z)), cvt_pk_bf16(y[6] * bflo(bb.w), y[7] * bfhi(bb.w))};
        *(u32x4*)(acat + (size_t)tok * DM + 1536 + ch) = w;
    }
}

__device__ __forceinline__ void qkv_prep_phase(const Params& P, int l, int wv) {
    const bf16_t* p = (const bf16_t*)(P.ws + WS_P); const bf16_t* zq = (const bf16_t*)(P.ws + WS_ZQ); const bf16_t* zkv = (const bf16_t*)(P.ws + WS_H);
    bf16_t* Q = (bf16_t*)(P.ws + WS_Q); bf16_t* Qc = (bf16_t*)(P.ws + WS_QC); bf16_t* Kb = (bf16_t*)(P.ws + WS_K); bf16_t* Vb = (bf16_t*)(P.ws + WS_V);
    const float* ROPE = (const float*)(P.ws + WS_ROPE);
    const float* qn = P.in[I_QN] + l * QKH; const float* kn = P.in[I_KN] + l * QKH;
    const int tid = TID(wv), lane = tid & 63, gw = BID() * 8 + (tid >> 6), nw = GDIM() * 8;
    const int h = lane >> 3, s8 = (lane & 7) * 8;
    f32x4 qg[3][2], kg[3][2];
#pragma unroll
    for (int j = 0; j < 3; ++j) { qg[j][0] = *(const f32x4*)(qn + 64 * j + s8); qg[j][1] = *(const f32x4*)(qn + 64 * j + s8 + 4); kg[j][0] = *(const f32x4*)(kn + 64 * j + s8); kg[j][1] = *(const f32x4*)(kn + 64 * j + s8 + 4); }
#define UNPK(W_, f) do { const u32x4 _u = (W_); f[0] = bflo(_u.x); f[1] = bfhi(_u.x); f[2] = bflo(_u.y); f[3] = bfhi(_u.y); f[4] = bflo(_u.z); f[5] = bfhi(_u.z); f[6] = bflo(_u.w); f[7] = bfhi(_u.w); } while (0)
#define PK8(f) (u32x4){cvt_pk_bf16(f[0], f[1]), cvt_pk_bf16(f[2], f[3]), cvt_pk_bf16(f[4], f[5]), cvt_pk_bf16(f[6], f[7])}
    u32x4 n_pa, n_wkr, n_wq[3], n_wk0, n_wk1, n_wv0, n_wv1; u32x2 n_pb; f32x4 n_r[4];
#define QP_LOAD(tok_) do { const bf16_t* pr_ = p + (size_t)(tok_) * NINP; const bool lat_ = (tok_) < ML; const int t_ = lat_ ? ((tok_) & (SEQ - 1)) : 0; \
        const bf16_t* zqr_ = zq + (size_t)(tok_) * 1536 + h * QKH + s8; const bf16_t* zkr_ = zkv + (size_t)(tok_) * 2048 + h * 256 + s8; \
        n_pa = *(const u32x4*)(pr_ + OFF_CQ + lane * 8); n_pb = *(const u32x2*)(pr_ + OFF_CKV + lane * 4); n_wkr = *(const u32x4*)(pr_ + OFF_KR + s8); \
        n_wq[0] = *(const u32x4*)(zqr_); n_wq[1] = *(const u32x4*)(zqr_ + 64); n_wq[2] = *(const u32x4*)(zqr_ + 128);     \
        n_wk0 = *(const u32x4*)(zkr_); n_wk1 = *(const u32x4*)(zkr_ + 64); n_wv0 = *(const u32x4*)(zkr_ + 128); n_wv1 = *(const u32x4*)(zkr_ + 192); \
        const float* rp_ = ROPE + ((size_t)t_ * 32 + (s8 & 31)) * 2; n_r[0] = *(const f32x4*)rp_; n_r[1] = *(const f32x4*)(rp_ + 4); n_r[2] = *(const f32x4*)(rp_ + 8); n_r[3] = *(const f32x4*)(rp_ + 12); } while (0)
    int tokn = gw;
    if (tokn >= MA) return;
    QP_LOAD(tokn);
    for (;;) {
        const int tok = tokn;
        const bool lat = tok < ML;
        int b, t; if (lat) { b = tok >> 12; t = tok & (SEQ - 1); } else { b = (tok - ML) >> 8; t = (tok - ML) & (CTXL - 1); }
        const bool needq = lat || (l == 0);
        const u32x4 pa = n_pa, wkr = n_wkr, wk0 = n_wk0, wk1 = n_wk1, wv0 = n_wv0, wv1 = n_wv1; const u32x2 pb = n_pb;
        u32x4 wq[3] = {n_wq[0], n_wq[1], n_wq[2]};
        const f32x4 r0 = n_r[0], r1 = n_r[1], r2 = n_r[2], r3 = n_r[3];
        const int ntok = tok + nw; const bool more = ntok < MA;
        if (more) QP_LOAD(ntok);
        float cs[8], sn[8];
        if (lat) {
            cs[0] = r0[0]; sn[0] = r0[1]; cs[1] = r0[2]; sn[1] = r0[3]; cs[2] = r1[0]; sn[2] = r1[1]; cs[3] = r1[2]; sn[3] = r1[3];
            cs[4] = r2[0]; sn[4] = r2[1]; cs[5] = r2[2]; sn[5] = r2[3]; cs[6] = r3[0]; sn[6] = r3[1]; cs[7] = r3[2]; sn[7] = r3[3]; }
        else {
#pragma unroll
            for (int e = 0; e < 8; ++e) { cs[e] = 1.f; sn[e] = 0.f; } }
        float fa[8]; UNPK(pa, fa);
        float sq = 0.f;
#pragma unroll
        for (int e = 0; e < 8; ++e) sq += fa[e] * fa[e];
        float skv = bflo(pb.x) * bflo(pb.x) + bfhi(pb.x) * bfhi(pb.x) + bflo(pb.y) * bflo(pb.y) + bfhi(pb.y) * bfhi(pb.y);
        sq = wave_sum(sq); skv = wave_sum(skv);
        const float rq = 1.0f / sqrtf(sq * (1.0f / 512.0f) + EPS), rkv = 1.0f / sqrtf(skv * (1.0f / 256.0f) + EPS);
        const int kpos = lat ? CTXL + t : t;
        const float sgn = (lane & 4) ? 1.f : -1.f;
        if (needq) {
            float e[3][8]; float ss = 0.f;
#pragma unroll
            for (int j = 0; j < 3; ++j) { UNPK(wq[j], e[j]);
#pragma unroll
                for (int i = 0; i < 8; ++i) { e[j][i] *= rq; ss += e[j][i] * e[j][i]; } }
            ss += __shfl_xor(ss, 1); ss += __shfl_xor(ss, 2); ss += __shfl_xor(ss, 4);
            const float rn = 1.0f / sqrtf(ss * (1.0f / QKH) + EPS);
#pragma unroll
            for (int j = 0; j < 3; ++j)
#pragma unroll
                for (int i = 0; i < 8; ++i) e[j][i] *= rn * qg[j][i >> 2][i & 3];
#pragma unroll
            for (int i = 0; i < 8; ++i) { const float part = __shfl_xor(e[2][i], 4); e[2][i] = e[2][i] * cs[i] + sgn * part * sn[i]; }
            bf16_t* qo = (lat ? Q + ((size_t)(b * NH + h) * SEQ + t) * QKH : Qc + ((size_t)(b * NH + h) * CTXL + t) * QKH) + s8;
            *(u32x4*)(qo) = PK8(e[0]); *(u32x4*)(qo + 64) = PK8(e[1]); *(u32x4*)(qo + 128) = PK8(e[2]);
        }
        {
            float k[3][8]; float ss = 0.f; UNPK(wk0, k[0]); UNPK(wk1, k[1]); UNPK(wkr, k[2]);
#pragma unroll
            for (int i = 0; i < 8; ++i) { k[0][i] *= rkv; k[1][i] *= rkv; ss += k[0][i] * k[0][i] + k[1][i] * k[1][i] + k[2][i] * k[2][i]; }
            ss += __shfl_xor(ss, 1); ss += __shfl_xor(ss, 2); ss += __shfl_xor(ss, 4);
            const float rn = 1.0f / sqrtf(ss * (1.0f / QKH) + EPS);
#pragma unroll
            for (int j = 0; j < 3; ++j)
#pragma unroll
                for (int i = 0; i < 8; ++i) k[j][i] *= rn * kg[j][i >> 2][i & 3];
#pragma unroll
            for (int i = 0; i < 8; ++i) { const float part = __shfl_xor(k[2][i], 4); k[2][i] = k[2][i] * cs[i] + sgn * part * sn[i]; }
            bf16_t* ko = Kb + ((size_t)(b * NH + h) * TK + kpos) * QKH + s8;
            *(u32x4*)(ko) = PK8(k[0]); *(u32x4*)(ko + 64) = PK8(k[1]); *(u32x4*)(ko + 128) = PK8(k[2]);
            float v0[8], v1[8]; UNPK(wv0, v0); UNPK(wv1, v1);
#pragma unroll
            for (int i = 0; i < 8; ++i) { v0[i] *= rkv; v1[i] *= rkv; }
            bf16_t* vo = Vb + ((size_t)(b * NH + h) * TK + kpos) * VH + s8;
            *(u32x4*)(vo) = PK8(v0); *(u32x4*)(vo + 64) = PK8(v1);
        }
        if (!more) break;
        tokn = ntok;
    }
#undef QP_LOAD
#undef UNPK
#undef PK8
}

constexpr int LDS_BYTES = g8::STAGE_BYTES;
static_assert(at::SHM_ATTN2 <= (size_t)LDS_BYTES && 4 * 64 * 65 * 4 <= LDS_BYTES, "LDS budget");
constexpr int N_PHASES = 1 + 2 * 10;

template <int PH>
__device__ __forceinline__ void run_phase(const Params& P0, LAS unsigned char* lds, unsigned char* lds_raw, int wv, int vb) {
    size_t z = 0; asm volatile("" : "+s"(z));
    int bid_ = vb; asm volatile("" : "+s"(bid_));
    const int G = GDIM(), bid = bid_;
    Params P;
#pragma unroll
    for (int i = 0; i < 24; ++i) P.in[i] = P0.in[i] + z;
    P.out = P0.out + z; P.ws = P0.ws + z; P.ph_lo = 0; P.ph_hi = 0;
    unsigned char* ws = P.ws;
    bf16_t* Hb = (bf16_t*)(ws + WS_H); bf16_t* Pb = (bf16_t*)(ws + WS_P); bf16_t* ZQ = (bf16_t*)(ws + WS_ZQ);
    bf16_t* ACAT = (bf16_t*)(ws + WS_ACAT); bf16_t* XA = (bf16_t*)(ws + WS_XA); float* modall = (float*)(ws + WS_MOD);
    constexpr int ph = PH;
    {
        if (ph == 0) { PHON(10) { adaln_phase(P, wv); dft_phase(P, wv); wprep_phase(P, 0, lds_raw, wv); } return; }
        constexpr int l = (ph - 1) / 10, sp = (ph - 1) % 10;
        const float* mod = modall + (size_t)l * 3 * 12288;
        constexpr int nMl = (l == 0) ? 34 : 32;
        bf16_t* XAc = XA + (size_t)ML * DM;
        switch (sp) {
        case 0: PHON(0) {
            if (l == 1) wprep_phase(P, 1, lds_raw, wv);
            if (l == 0) norm_phase<false, false>(P.in[I_X], P.in[I_CTX], MA, P.in[I_NMIX] + l * DM, mod, 0, Hb, wv);
            else norm_phase<true, true>(XA, XAc, MA, P.in[I_NMIX] + l * DM, mod, 0, Hb, wv, (const float*)(ws + WS_SLAB), 11, modall + 2 * 12288 + 5 * DM, XAc);
        } break;
        case 1: PHON(1) {
            g8::Gemm g{Hb, (const bf16_t*)(ws + WS_WIN), DM, DM, DM}; g8::Order S;
            if (l == 0) S.init(34, 36, G, bid); else S.init(32, 36, G, bid, 32, 4, 2, 2);
            g8::EpiBf16 E{Pb, NINP, 0, 0, 0, (const float*)(ws + WS_BIAS)};
            g8::gemm_phase<g8::EpiBf16>(lds, g, S, E, wv);
        } break;
        case 2: PHON(2) {
            { g8::Gemm g{Pb + OFF_CQ, (const bf16_t*)(ws + WS_WUQ), NINP, 512, 512}; g8::Order S; S.init(nMl, 6, G, bid);
              g8::EpiBf16 E{ZQ, 1536, 0, 0, 0, nullptr}; g8::gemm_phase<g8::EpiBf16>(lds, g, S, E, wv); }
            { g8::Gemm g{Pb + OFF_CKV, (const bf16_t*)(ws + WS_WUKV), NINP, 256, 256}; g8::Order S; S.init(34, 8, G, (bid + 64) % G);
              g8::EpiBf16 E{Hb, 2048, 0, 0, 0, nullptr}; g8::gemm_phase<g8::EpiBf16>(lds, g, S, E, wv); }
            { g8::Gemm g{(const bf16_t*)(ws + WS_BD), Pb + OFF_F, 512, NINP, 512}; g8::Order S; S.init(4, 32, G, (bid + G - 16) % G);
              g8::EpiF1 E{(bf16_t*)(ws + WS_GT), (bf16_t*)(ws + WS_GTC), 0}; g8::gemm_phase<g8::EpiF1, 1>(lds, g, S, E, wv); }
            if (l == 0) { g8::Gemm g{(const bf16_t*)(ws + WS_BD), Pb + (size_t)ML * NINP + OFF_F, 512, NINP, 512}; g8::Order S; S.init(4, 2, G, (bid + G - 144) % G);
              g8::EpiF1 E{(bf16_t*)(ws + WS_GT), (bf16_t*)(ws + WS_GTC), 32}; g8::gemm_phase<g8::EpiF1, 0>(lds, g, S, E, wv); }
            conv_phase(Pb, P.in[I_CONVW] + l * 3 * 512, ACAT, nMl * 256, wv);
        } break;
        case 3: PHON(3) {
            qkv_prep_phase(P, l, wv);
            __syncthreads();
            { g8::Gemm g{(const bf16_t*)(ws + WS_DB), (const bf16_t*)(ws + WS_GT), 128, 64, 128, 128, 8192}; g8::Order S; S.init(1, 256, G, bid);
              g8::EpiTw E{(bf16_t*)(ws + WS_VP), (const float*)(ws + WS_TW)}; g8::gemm_phase<g8::EpiTw, 2>(lds, g, S, E, wv); }
        } break;
        case 4: PHON(4) {
            const bf16_t* Q = (const bf16_t*)(ws + WS_Q); const bf16_t* Qc = (const bf16_t*)(ws + WS_QC);
            const bf16_t* Kb = (const bf16_t*)(ws + WS_K); const bf16_t* Vb = (const bf16_t*)(ws + WS_V);
            for (int it = bid; it < 256; it += G) {
                const int xcd = it & 7, slot = it >> 3, bh = xcd * 2 + (slot >> 4), qb = slot & 15, b = bh >> 3, h = bh & 7;
                at::attn_body(Q + ((size_t)bh * SEQ + qb * 256) * QKH, Kb + (size_t)bh * TK * QKH, Vb + (size_t)bh * TK * VH,
                              ACAT + (size_t)(b * SEQ + qb * 256) * DM + 512 + h * VH, DM, TK, (char*)lds_raw, wv);
                __syncthreads();
            }
#ifndef X_NOCTXATT
            if (l == 0) for (int it = bid; it < 16; it += G) {
                const int bh = it, b = bh >> 3, h = bh & 7;
                at::attn_body(Qc + (size_t)bh * CTXL * QKH, Kb + (size_t)bh * TK * QKH, Vb + (size_t)bh * TK * VH,
                              ACAT + (size_t)(ML + b * CTXL) * DM + 512 + h * VH, DM, CTXL, (char*)lds_raw, wv);
                __syncthreads();
            }
#endif
#ifndef X_NOF2
            { g8::Gemm g{(const bf16_t*)(ws + WS_DC), (const bf16_t*)(ws + WS_VP), 128, 128, 128}; g8::Order S; S.init(1, 256, G, bid);
              g8::EpiFm2 E{ACAT}; g8::gemm_phase<g8::EpiFm2>(lds, g, S, E, wv); }
            if (l == 0) { g8::Gemm g{(const bf16_t*)(ws + WS_A2C), (const bf16_t*)(ws + WS_GTC), 512, 512, 512}; g8::Order S; S.init(1, 4, 4, (bid >= 16 && bid < 20) ? bid - 16 : -1);
              g8::EpiBf16 E{ACAT, DM, 2, (size_t)CTXL * DM, ML, nullptr}; g8::gemm_phase<g8::EpiBf16>(lds, g, S, E, wv); }
#endif
        } break;
        case 5: PHON(5) {
            g8::Gemm g{ACAT, (const bf16_t*)(ws + WS_WMG), DM, DM, DM}; g8::Order S;
            if (l == 0) S.init(32, 8, G, bid, 32, 0, 2, 8, 4, 512); else S.init(32, 8, G, bid);
            g8::EpiMerge E{Pb, Hb, (float*)(ws + WS_SLAB), (unsigned*)(ws + WS_CNT)}; g8::gemm_phase<g8::EpiMerge>(lds, g, S, E, wv);
        } break;
        case 6: PHON(6) {
            g8::Gemm g{Hb, (const bf16_t*)(ws + WS_WOUT), DM, DM, DM}; g8::Order S;
            if (l == 0) S.init(32, 8, G, bid, 32, 0, 2, 8, 8, 256); else S.init(32, 8, G, bid);
            if (l == 0) { g8::EpiResid<false, true> E{P.in[I_X], P.in[I_CTX], XA, XAc, mod + 2 * DM, (float*)(ws + WS_SLAB)}; g8::gemm_phase<g8::EpiResid<false, true>>(lds, g, S, E, wv); }
            else { g8::EpiResid<true, true> E{XA, XAc, XA, XAc, mod + 2 * DM, (float*)(ws + WS_SLAB)}; g8::gemm_phase<g8::EpiResid<true, true>>(lds, g, S, E, wv); }
        } break;
        case 7: PHON(7) {
            if (l == 0) norm_phase<true, false>(XA, P.in[I_CTX], MA, P.in[I_NFFN] + l * DM, mod, 3, Hb, wv, (const float*)(ws + WS_SLAB), 8, mod + 2 * 12288 + 2 * DM, XAc);
            else norm_phase<true, true>(XA, XAc, nMl * 256, P.in[I_NFFN] + l * DM, mod, 3, Hb, wv);
        } break;
        case 8: PHON(8) {
            g8::Gemm g{Hb, (const bf16_t*)(ws + WS_WGU), DM, DM, DM}; g8::Order S; S.init(nMl, 44, G, bid);
            g8::EpiSwiglu E{Pb}; g8::gemm_phase<g8::EpiSwiglu>(lds, g, S, E, wv);
        } break;
        default: PHON(9) {
            g8::Gemm g{Pb, (const bf16_t*)(ws + WS_WD), DFF, DFF, DFF}; g8::Order S;
            if (l == 0) S.init(32, 8, G, bid, 32, 0, 2, 8, 11, 512); else S.init(32, 8, G, bid);
            if (l == 0) { g8::EpiResid<true, true> E{XA, XAc, XA, XAc, mod + 5 * DM, (float*)(ws + WS_SLAB)}; g8::gemm_phase<g8::EpiResid<true, true>>(lds, g, S, E, wv); }
            else { g8::EpiResid<true, false> E{XA, XAc, P.out, P.out, mod + 5 * DM, (float*)(ws + WS_SLAB)}; g8::gemm_phase<g8::EpiResid<true, false>>(lds, g, S, E, wv); }
        } break;
        }

    }
}

__global__ void __launch_bounds__(512, 2) mk_fwd(Params P0) {
    extern __shared__ __attribute__((aligned(16))) unsigned char lds_raw[];
    LAS unsigned char* lds = (LAS unsigned char*)lds_raw;
    const int lo = P0.ph_lo, hi = P0.ph_hi;
    const int wv = __builtin_amdgcn_readfirstlane((int)threadIdx.x >> 6);
    unsigned* barw = (unsigned*)(P0.ws + WS_XBAR);
    if (hi < 0) cg::this_grid().sync();
    XBar xb; xb.w = barw; xb.xcc = 0; xb.nx = 0; xb.nxcc = 0; xb.uniform = 0;
    int vb = (int)blockIdx.x; unsigned rank = 0;
    if (lo == 0) { const unsigned r0 = xbar_post(barw, wv);
        if (threadIdx.x == 0) *(volatile unsigned*)lds_raw = r0;
        __syncthreads(); rank = (unsigned)__builtin_amdgcn_readfirstlane((int)*(volatile unsigned*)lds_raw); __syncthreads(); }
    unsigned nbar = 0;
#ifndef MK_REPEAT_MASK
#define MK_REPEAT_MASK 0u
#endif
#define RUN(k) if (lo <= (k) && (k) < hi) { if ((k) > lo) { if ((k) == 1) { grid_barrier_first((unsigned*)(P0.ws + WS_BAR), gridDim.x, wv); xb = xbar_setup(barw); if (xb.uniform && gridDim.x == 256) vb = (int)(rank * 8u + xb.xcc); } else grid_barrier(xb, ++nbar, wv); } run_phase<(k)>(P0, lds, lds_raw, wv, vb); \
        if constexpr ((MK_REPEAT_MASK >> (k)) & 1u) { grid_barrier(xb, ++nbar, wv); run_phase<(k)>(P0, lds, lds_raw, wv, vb); } }
    RUN(0) RUN(1) RUN(2) RUN(3) RUN(4) RUN(5) RUN(6) RUN(7) RUN(8) RUN(9) RUN(10)
    RUN(11) RUN(12) RUN(13) RUN(14) RUN(15) RUN(16) RUN(17) RUN(18) RUN(19) RUN(20)
#undef RUN
}

extern "C" void kernel_launch(void* const* d_in, const int* in_sizes, int n_in, void* d_out, int out_size, void* d_ws, size_t ws_size, hipStream_t stream) {
    static int grid = 0;
    if (grid == 0) {
        if (n_in != 24 || out_size != ML * DM || ws_size < WS_END) { fprintf(stderr, "kernel_launch: unexpected shapes (n_in %d out %d ws %zu need %zu)\n", n_in, out_size, ws_size, (size_t)WS_END); grid = -1; return; }
        int dev = 0, cus = 0, per_cu = 0;
        hipGetDevice(&dev); hipDeviceGetAttribute(&cus, hipDeviceAttributeMultiprocessorCount, dev);
        if (hipFuncSetAttribute((const void*)mk_fwd, hipFuncAttributeMaxDynamicSharedMemorySize, LDS_BYTES) != hipSuccess) { fprintf(stderr, "kernel_launch: hipFuncSetAttribute failed\n"); grid = -1; return; }
        if (hipOccupancyMaxActiveBlocksPerMultiprocessor(&per_cu, (const void*)mk_fwd, 512, LDS_BYTES) != hipSuccess || per_cu < 1) { fprintf(stderr, "kernel_launch: occupancy query says %d\n", per_cu); per_cu = 1; }
        (void)hipGetLastError();
        grid = cus * 1;
    }
    if (grid < 0) return;
    hipMemsetAsync((char*)d_ws + WS_MOD, 0, WS_ZERO_BYTES, stream);
    Params p{};
    for (int i = 0; i < 24; ++i) p.in[i] = (const float*)d_in[i];
    p.out = (float*)d_out; p.ws = (unsigned char*)d_ws;
#if MK_PER_PHASE
    for (int ph = 0; ph < N_PHASES; ++ph) { p.ph_lo = ph; p.ph_hi = ph + 1; hipLaunchKernelGGL(mk_fwd, dim3(grid), dim3(512), LDS_BYTES, stream, p); }
#else
    p.ph_lo = 0; p.ph_hi = N_PHASES;
    void* args[] = {&p};
    hipError_t e = hipLaunchCooperativeKernel((const void*)mk_fwd, dim3(grid), dim3(512), args, LDS_BYTES, stream);
    if (e != hipSuccess) fprintf(stderr, "kernel_launch: cooperative launch failed: %s (grid %d)\n", hipGetErrorString(e), grid);
#endif
}
```

```cpp
#include <hip/hip_runtime.h>
#include <hip/hip_cooperative_groups.h>
#include <cstdio>
#include <cstdint>
namespace cg = cooperative_groups;

#ifndef MK_MASK
#define MK_MASK 0xFFFF
#endif
#define PHON(b) if constexpr ((MK_MASK >> (b)) & 1)
#ifndef MK_PER_PHASE
#define MK_PER_PHASE 0
#endif

typedef unsigned short bf16_t;
typedef short bf16x8 __attribute__((ext_vector_type(8)));
typedef short s16x4 __attribute__((ext_vector_type(4)));
typedef float f32x2 __attribute__((ext_vector_type(2)));
typedef float f32x4 __attribute__((ext_vector_type(4)));
typedef float f32x16 __attribute__((ext_vector_type(16)));
typedef unsigned u32x2 __attribute__((ext_vector_type(2)));
typedef unsigned u32x4 __attribute__((ext_vector_type(4)));
#define LAS __attribute__((address_space(3)))

constexpr int DM = 2048, SEQ = 4096, NB = 2, CTXL = 256, ML = NB * SEQ  , MC = NB * CTXL  , MA = ML + MC  ;
constexpr int NIN = 9024, NINP = 9216, DFF = 5632, NH = 8, QKH = 192, VH = 128, TK = SEQ + CTXL  ;
constexpr int OFF_F = 0, OFF_CQ = 512, OFF_CKV = 1024, OFF_KR = 1280, OFF_CX = 1344, OFF_CB = 1856, OFF_CC = 2368, OFF_G = 2880;
constexpr float EPS = 1e-6f;

constexpr size_t al256(size_t x) { return (x + 255) / 256 * 256; }
constexpr size_t WS_MOD  = 0;
constexpr size_t WS_BAR  = al256(WS_MOD + (size_t)2 * 3 * 12288 * 4);
constexpr size_t WS_CNT  = WS_BAR + 256;
constexpr size_t WS_XBAR = WS_CNT + 1024;
constexpr size_t WS_ZERO_BYTES = WS_XBAR + 64 * 49 * 4;
constexpr size_t WS_WIN  = al256(WS_XBAR + 64 * 49 * 4);
constexpr size_t WS_WUQ  = WS_WIN + (size_t)NINP * DM * 2;
constexpr size_t WS_WUKV = WS_WUQ + (size_t)1536 * 512 * 2;
constexpr size_t WS_WMG  = WS_WUKV + (size_t)2048 * 256 * 2;
constexpr size_t WS_WOUT = WS_WMG + (size_t)2048 * 2048 * 2;
constexpr size_t WS_WGU  = WS_WOUT + (size_t)2048 * 2048 * 2;
constexpr size_t WS_WD   = WS_WGU + (size_t)2 * DFF * DM * 2;
constexpr size_t WS_BD   = WS_WD + (size_t)DM * DFF * 2;
constexpr size_t WS_VP   = WS_BD + (size_t)1024 * 512 * 2;
constexpr size_t WS_DB   = WS_VP + (size_t)64 * 1024 * 128 * 2;
constexpr size_t WS_DC   = WS_DB + (size_t)256 * 128 * 2;
constexpr size_t WS_TW   = WS_DC + (size_t)256 * 128 * 2;
constexpr size_t WS_A2C  = WS_TW + (size_t)64 * 64 * 2 * 4;
constexpr size_t WS_H    = WS_A2C + (size_t)256 * 512 * 2;
constexpr size_t WS_P    = WS_H + (size_t)MA * DM * 2;
constexpr size_t WS_ZQ   = WS_P + (size_t)MA * NINP * 2;
constexpr size_t WS_GT   = WS_ZQ + (size_t)MA * 1536 * 2;
constexpr size_t WS_GTC  = WS_GT + (size_t)1024 * 8192 * 2;
constexpr size_t WS_Q    = WS_GTC + (size_t)1024 * 512 * 2;
constexpr size_t WS_QC   = WS_Q + (size_t)NB * NH * SEQ * QKH * 2;
constexpr size_t WS_K    = WS_QC + (size_t)NB * NH * CTXL * QKH * 2;
constexpr size_t WS_V    = WS_K + (size_t)NB * NH * TK * QKH * 2;
constexpr size_t WS_ACAT = WS_V + (size_t)NB * NH * TK * VH * 2;
constexpr size_t WS_XA   = WS_ACAT + (size_t)MA * DM * 2;
constexpr size_t WS_BIAS = WS_XA + (size_t)MA * DM * 4;
constexpr size_t WS_ROPE = al256(WS_BIAS + (size_t)NINP * 4);
constexpr size_t WS_SLAB = WS_ROPE + (size_t)SEQ * 32 * 2 * 4;
constexpr size_t WS_END  = WS_SLAB + (size_t)11 * MC * DM * 4;

struct Params { const float* in[24]; float* out; unsigned char* ws; int ph_lo, ph_hi; };
enum { I_X = 0, I_C, I_CTX, I_CCTX, I_WADA, I_BADA, I_NMIX, I_NFFN, I_WIN, I_BGATE, I_QAN, I_KVAN, I_WUQ, I_WUKV, I_QN, I_KN,
       I_WF, I_WMLA, I_CONVW, I_WCONV, I_WOUT, I_WG, I_WU, I_WDN };

__device__ __forceinline__ int TID(int wv) { int t = (wv << 6) | (int)__builtin_amdgcn_mbcnt_hi(~0u, __builtin_amdgcn_mbcnt_lo(~0u, 0u)); asm volatile("" : "+v"(t)); return t; }
__device__ __forceinline__ int BID() { int t = blockIdx.x; asm volatile("" : "+s"(t)); return t; }
__device__ __forceinline__ int GDIM() { int t = gridDim.x; asm volatile("" : "+s"(t)); return t; }
__device__ __forceinline__ unsigned cvt_pk_bf16(float lo, float hi) { unsigned r; asm volatile("v_cvt_pk_bf16_f32 %0, %1, %2" : "=v"(r) : "v"(lo), "v"(hi)); return r; }
__device__ __forceinline__ float bf2f(bf16_t v) { return __uint_as_float(((unsigned)v) << 16); }
__device__ __forceinline__ float bflo(unsigned w) { return __uint_as_float(w << 16); }
__device__ __forceinline__ float bfhi(unsigned w) { return __uint_as_float(w & 0xffff0000u); }
__device__ __forceinline__ bf16_t f2bf(float f) { return (bf16_t)(cvt_pk_bf16(f, 0.f) & 0xffffu); }
__device__ __forceinline__ float wave_sum(float v) {
#pragma unroll
    for (int o = 32; o >= 1; o >>= 1) v += __shfl_xor(v, o);
    return v;
}
__device__ __forceinline__ float sigmoidf_(float z) { return __builtin_amdgcn_rcpf(1.0f + __expf(-z)); }

struct XBar { unsigned* w; unsigned xcc, nx, nxcc; };
__device__ __forceinline__ unsigned xb_xcc_id() { return (unsigned)__builtin_amdgcn_s_getreg((3 << 11) | 20) & 0xFu; }
__device__ __forceinline__ unsigned xb_ld(unsigned* p) { return __hip_atomic_load(p, __ATOMIC_RELAXED, __HIP_MEMORY_SCOPE_AGENT); }
__device__ __forceinline__ void xbar_post(unsigned* w, int wv) {
    if (wv == 0 && __builtin_amdgcn_mbcnt_hi(~0u, __builtin_amdgcn_mbcnt_lo(~0u, 0u)) == 0u) __hip_atomic_fetch_add(w + 64 * xb_xcc_id(), 1u, __ATOMIC_RELAXED, __HIP_MEMORY_SCOPE_AGENT);
}
__device__ __forceinline__ XBar xbar_setup(unsigned* w) {
    XBar b; b.w = w; b.xcc = xb_xcc_id(); unsigned nx = 0, nxcc = 0;
    for (int j = 0; j < 16; ++j) { const unsigned cj = xb_ld(w + 64 * j); nxcc += cj ? 1u : 0u; if ((unsigned)j == b.xcc) nx = cj; }
    b.nx = (unsigned)__builtin_amdgcn_readfirstlane((int)nx); b.nxcc = (unsigned)__builtin_amdgcn_readfirstlane((int)nxcc); return b;
}
__device__ __forceinline__ void grid_barrier_first(unsigned* cnt, unsigned target, int wv) {
    asm volatile("s_waitcnt vmcnt(0)" ::: "memory");
    __syncthreads();
    if (wv == 0) {
        const int lane = (int)__builtin_amdgcn_mbcnt_hi(~0u, __builtin_amdgcn_mbcnt_lo(~0u, 0u));
        if (lane == 0) {
            __builtin_amdgcn_fence(__ATOMIC_RELEASE, "agent");
            asm volatile("s_waitcnt vmcnt(0)" ::: "memory");
            __hip_atomic_fetch_add(cnt, 1u, __ATOMIC_RELAXED, __HIP_MEMORY_SCOPE_AGENT);
            while (xb_ld(cnt) < target) __builtin_amdgcn_s_sleep(1);
            __builtin_amdgcn_fence(__ATOMIC_ACQUIRE, "agent");
            asm volatile("s_waitcnt vmcnt(0)" ::: "memory");
        }
    }
    __syncthreads();
}
__device__ __forceinline__ void grid_barrier(const XBar& b, unsigned k, int wv) {
    asm volatile("s_waitcnt vmcnt(0)" ::: "memory");
    __syncthreads();
    if (wv == 0) {
        const int lane = (int)__builtin_amdgcn_mbcnt_hi(~0u, __builtin_amdgcn_mbcnt_lo(~0u, 0u));
        if (lane == 0) {
            unsigned* xsub = b.w + 64 * (16 + b.xcc); unsigned* xgen = b.w + 64 * (32 + b.xcc); unsigned* top = b.w + 64 * 48;
            const unsigned old = __hip_atomic_fetch_add(xsub, 1u, __ATOMIC_RELAXED, __HIP_MEMORY_SCOPE_AGENT);
            if (old + 1u == k * b.nx) {
                __builtin_amdgcn_fence(__ATOMIC_RELEASE, "agent");
                asm volatile("s_waitcnt vmcnt(0)" ::: "memory");
                __hip_atomic_fetch_add(top, 1u, __ATOMIC_RELAXED, __HIP_MEMORY_SCOPE_AGENT);
            }
            (void)xgen;
            while (xb_ld(top) < k * b.nxcc) __builtin_amdgcn_s_sleep(2);
            __builtin_amdgcn_fence(__ATOMIC_ACQUIRE, "agent");
            asm volatile("s_waitcnt vmcnt(0)" ::: "memory");
        }
    }
    __syncthreads();
}

namespace g8 {
constexpr int BM = 256, BK = 64, HALF = 128, HTB = HALF * BK * 2, STAGE_BYTES = 8 * HTB, NXCD = 8, WGM = 8;
__device__ __forceinline__ int lds_byte(int r, int c) { const int st = (r >> 4) * 2 + (c >> 5), rr = r & 15, cc = c & 31, ob = rr * 64 + cc * 2; return st * 1024 + (ob ^ (((ob >> 9) & 1) << 5)); }
__device__ __forceinline__ void stage_rc(int b, int& R, int& C) { const int st = b / 1024, sb = b % 1024, swz = sb ^ (((sb >> 9) & 1) << 5); R = (st >> 1) * 16 + swz / 64; C = (st & 1) * 32 + (swz % 64) / 2; }
__device__ __forceinline__ int perm32(int rho) { const int n = rho >> 4, i = rho & 15; return 8 * (i >> 2) + 4 * n + (i & 3); }
struct Unit { int pm, pn, ks; };
struct Gemm { const bf16_t* A; const bf16_t* Bt; int lda, ldb, K; int kstepA = BK * 2, kstepB = BK * 2; };
struct Order {
    int nM, nN, nwg, G, c, eM0, eN0, eM, eN, eS, klen;
    __device__ void init(int nM_, int nN_, int G_, int c_, int eM0_ = 0, int eN0_ = 0, int eM_ = 0, int eN_ = 0, int eS_ = 0, int klen_ = 0) { nM = nM_; nN = nN_; nwg = nM * nN; G = G_; c = c_; eM0 = eM0_; eN0 = eN0_; eM = eM_; eN = eN_; eS = eS_; klen = klen_; }
    __device__ __forceinline__ bool next(int i, Unit& u) const {
        const int L = i * G + c;
        int pm = 0, pn = 0, ks = -1; bool ok = false;
        if (c >= 0) {
            if (L < nwg) {
                int wgid = L; { const int q = nwg / NXCD, r = nwg % NXCD, xcd = wgid % NXCD, off = wgid / NXCD; wgid = (xcd < r ? xcd * (q + 1) : r * (q + 1) + (xcd - r) * q) + off; }
                const int nig = WGM * nN, gid = wgid / nig, fm = gid * WGM, gsz = (nM - fm) < WGM ? (nM - fm) : WGM;
                pm = fm + ((wgid % nig) % gsz); pn = (wgid % nig) / gsz; ok = true;
            } else {
                const int Le = L - nwg, S1 = eS > 0 ? eS : 1;
                if (Le < eM * eN * S1) { const int ti = Le / S1; ks = eS > 0 ? Le % S1 : -1; pm = eM0 + ti % eM; pn = eN0 + ti / eM; ok = true; }
            }
        }
        u.pm = pm; u.pn = pn; u.ks = ks;
        return ok;
    }
};

template <class Epi, int BMODE = 0>
__device__ __forceinline__ void gemm_phase(LAS unsigned char* lds, const Gemm g, const Order& S, const Epi& E, int wv) {
    const int tid = TID(wv), wid = __builtin_amdgcn_readfirstlane(tid >> 6), lane = tid & 63, wr = wid >> 2, wc = wid & 3, fr = lane & 15, fq = lane >> 4;
    const int K = g.K, nt = K / BK;
    unsigned voffA, voffB;
    { int R, C; stage_rc(tid * 16, R, C); const int Rb = Epi::PERM ? ((R & ~31) + perm32(R & 31)) : R;
        const int rowB = BMODE == 0 ? Rb * g.ldb : (BMODE == 1 ? ((Rb >> 6) + 64 * (Rb & 63)) * g.ldb : (Rb >> 6) * 8192 + (Rb & 63) * 64);
        voffA = (unsigned)(R * g.lda + C) * 2u; voffB = (unsigned)(rowB + C) * 2u; }
    const size_t dA1 = (size_t)64 * g.lda * 2, dB1 = BMODE == 0 ? (size_t)64 * g.ldb * 2 : (BMODE == 1 ? (size_t)g.ldb * 2 : (size_t)8192 * 2);
    const size_t kstepA = (size_t)g.kstepA, kstepB = (size_t)g.kstepB;
    const size_t hstepA = (size_t)HALF * g.lda * 2, hstepB = BMODE == 0 ? (size_t)HALF * g.ldb * 2 : (BMODE == 1 ? (size_t)2 * g.ldb * 2 : (size_t)2 * 8192 * 2);
    const size_t tstepA = 2 * hstepA;
#define G8_BBASE(pn) ((const char*)g.Bt + (BMODE == 0 ? (size_t)(pn) * 2 * hstepB : (BMODE == 1 ? (size_t)((((pn) >> 4) * 4096) + ((pn) & 15) * 4) * g.ldb * 2 : (size_t)(pn) * 4 * 8192 * 2)))
    const unsigned ldsw = (unsigned)wid * 1024u;
    const int aoff = lds_byte(wr * 64 + fr, fq * 8), boff = lds_byte(wc * 32 + fr, fq * 8);
#define G8_SA(b, h) (((b) * 2 + (h)) * HTB)
#define G8_SB(b, h) ((4 + (b) * 2 + (h)) * HTB)
#define G8_STAGE(bufoff, gbase, voff) do { \
        __builtin_amdgcn_global_load_lds((const unsigned*)((const char*)(gbase) + (voff)), (LAS unsigned*)(lds + (bufoff) + ldsw), 16, 0, 0); \
        __builtin_amdgcn_global_load_lds((const unsigned*)((const char*)(gbase) + G8_D1(voff) + (voff)), (LAS unsigned*)(lds + (bufoff) + ldsw + 8192), 16, 0, 0); } while (0)
#define G8_D1(voff) (&(voff) == &voffA ? dA1 : dB1)
#define G8_LDA(dst, b, h) do { _Pragma("unroll") for (int m = 0; m < 4; ++m) _Pragma("unroll") for (int k = 0; k < 2; ++k) dst[m][k] = *(const LAS bf16x8*)(lds + G8_SA(b, h) + aoff + m * 2048 + k * 1024); } while (0)
#define G8_LDB(dst, b, h) do { _Pragma("unroll") for (int n = 0; n < 2; ++n) _Pragma("unroll") for (int k = 0; k < 2; ++k) dst[n][k] = *(const LAS bf16x8*)(lds + G8_SB(b, h) + boff + n * 2048 + k * 1024); } while (0)
#define G8_MMA(ai, bj, At, Bt) do { __builtin_amdgcn_s_setprio(1); _Pragma("unroll") for (int m = 0; m < 4; ++m) _Pragma("unroll") for (int n = 0; n < 2; ++n) _Pragma("unroll") for (int k = 0; k < 2; ++k) \
        acc[ai][bj][m][n] = __builtin_amdgcn_mfma_f32_16x16x32_bf16(Bt[n][k], At[m][k], acc[ai][bj][m][n], 0, 0, 0); __builtin_amdgcn_s_setprio(0); } while (0)
#define G8_WAIT_V(n) asm volatile("s_waitcnt vmcnt(" #n ")" ::: "memory")
#define G8_WAIT_L(n) asm volatile("s_waitcnt lgkmcnt(" #n ")" ::: "memory")
#define G8_BAR __builtin_amdgcn_s_barrier()
#define G8_SCHED __builtin_amdgcn_sched_barrier(0)
    Unit cur, nxt; int ui = 0;
    if (!S.next(0, cur)) return;
    f32x4 acc[2][2][4][2];
#pragma unroll
    for (int a = 0; a < 2; ++a)
#pragma unroll
        for (int b = 0; b < 2; ++b)
#pragma unroll
            for (int m = 0; m < 4; ++m)
#pragma unroll
                for (int n = 0; n < 2; ++n) acc[a][b][m][n] = (f32x4){0.f, 0.f, 0.f, 0.f};
    bf16x8 At[4][2], B0[2][2], B1[2][2];
#define G8_KOFF(u) ((u).ks >= 0 ? (size_t)(u).ks * S.klen * 2 : (size_t)0)
    const char* cA = (const char*)g.A + (size_t)cur.pm * tstepA + G8_KOFF(cur); const char* cB = G8_BBASE(cur.pn) + G8_KOFF(cur);
    G8_STAGE(G8_SB(0, 0), cB, voffB); G8_STAGE(G8_SA(0, 0), cA, voffA); G8_STAGE(G8_SB(0, 1), cB + hstepB, voffB); G8_STAGE(G8_SA(0, 1), cA + hstepA, voffA);
    if (wr == 1) G8_BAR;
    G8_WAIT_V(4); G8_BAR;
    G8_STAGE(G8_SB(1, 0), cB + kstepB, voffB); G8_STAGE(G8_SA(1, 0), cA + kstepA, voffA); G8_STAGE(G8_SB(1, 1), cB + hstepB + kstepB, voffB);
    G8_WAIT_V(6); G8_BAR;
    for (;;) {
        const bool has_next = S.next(ui + 1, nxt);
        const char* nA = has_next ? (const char*)g.A + (size_t)nxt.pm * tstepA + G8_KOFF(nxt) : cA; const char* nB = has_next ? G8_BBASE(nxt.pn) + G8_KOFF(nxt) : cB;
        const int ntu = cur.ks >= 0 ? S.klen / BK : nt;
        for (int t = 0; t < ntu; t += 2) {
            const bool last = (t == ntu - 2);
            const char* a1 = cA + (size_t)(t + 1) * kstepA;
            const char* a2 = last ? nA : cA + (size_t)(t + 2) * kstepA; const char* b2 = last ? nB : cB + (size_t)(t + 2) * kstepB;
            const char* a3 = a2 + kstepA; const char* b3 = b2 + kstepB;
            if constexpr (Epi::SEG) { if (t == Epi::SEG0 || t == Epi::SEG1) { const int t2 = TID(wv); E.seg(acc, cur, t, wr, wc, t2 & 15, (t2 >> 4) & 3); } }
            G8_LDB(B0, 0, 0); G8_SCHED; G8_LDA(At, 0, 0); G8_STAGE(G8_SA(1, 1), a1 + hstepA, voffA);
            G8_WAIT_L(8); G8_BAR; G8_WAIT_L(0); G8_MMA(0, 0, At, B0); G8_BAR; G8_SCHED;
            G8_LDB(B1, 0, 1); G8_STAGE(G8_SB(0, 0), b2, voffB);
            G8_BAR; G8_WAIT_L(0); G8_MMA(0, 1, At, B1); G8_BAR;
            G8_LDA(At, 0, 1); G8_STAGE(G8_SA(0, 0), a2, voffA);
            G8_BAR; G8_WAIT_L(0); G8_MMA(1, 0, At, B0); G8_BAR; G8_SCHED;
            G8_STAGE(G8_SB(0, 1), b2 + hstepB, voffB);
            G8_WAIT_V(6); G8_BAR; G8_MMA(1, 1, At, B1); G8_BAR;
            G8_LDB(B0, 1, 0); G8_SCHED; G8_LDA(At, 1, 0); G8_STAGE(G8_SA(0, 1), a2 + hstepA, voffA);
            G8_WAIT_L(8); G8_BAR; G8_WAIT_L(0); G8_MMA(0, 0, At, B0); G8_BAR; G8_SCHED;
            G8_LDB(B1, 1, 1); G8_STAGE(G8_SB(1, 0), b3, voffB);
            G8_BAR; G8_WAIT_L(0); G8_MMA(0, 1, At, B1); G8_BAR;
            G8_LDA(At, 1, 1); G8_STAGE(G8_SA(1, 0), a3, voffA);
            G8_BAR; G8_WAIT_L(0); G8_MMA(1, 0, At, B0); G8_BAR; G8_SCHED;
            G8_STAGE(G8_SB(1, 1), b3 + hstepB, voffB);
            G8_WAIT_V(6); G8_BAR; G8_MMA(1, 1, At, B1); G8_BAR;
        }
        { const int t2 = TID(wv); const int fr2 = t2 & 15, fq2 = (t2 >> 4) & 3; int wr2 = wr, wc2 = wc; asm volatile("" : "+s"(wr2), "+s"(wc2));
          E(acc, cur, wr2, wc2, fr2, fq2); }
        { int ui2 = ui + 1; asm volatile("" : "+s"(ui2)); if (!S.next(ui2, nxt)) break; }
#pragma unroll
        for (int a = 0; a < 2; ++a)
#pragma unroll
            for (int b = 0; b < 2; ++b)
#pragma unroll
                for (int m = 0; m < 4; ++m)
#pragma unroll
                    for (int n = 0; n < 2; ++n) acc[a][b][m][n] = (f32x4){0.f, 0.f, 0.f, 0.f};
        cur = nxt; cA = nA; cB = nB; ++ui;
    }
    G8_WAIT_V(0);
    if (wr == 0) G8_BAR;
    G8_BAR;
#undef G8_BBASE
#undef G8_KOFF
#undef G8_SA
#undef G8_SB
#undef G8_STAGE
#undef G8_D1
#undef G8_LDA
#undef G8_LDB
#undef G8_MMA
#undef G8_WAIT_V
#undef G8_WAIT_L
#undef G8_BAR
#undef G8_SCHED
}

struct EpiBf16 {
    static constexpr bool PERM = true, SEG = false; static constexpr int SEG0 = -1, SEG1 = -1;
    bf16_t* O; int ldc; int tps; size_t split_stride; int row_off; const float* bias;
    __device__ __forceinline__ void operator()(const f32x4 (&acc)[2][2][4][2], const Unit& u, int wr, int wc, int fr, int fq) const {
        const int row0 = row_off + u.pm * BM + wr * 64 + fr; bf16_t* base = O; int colt = u.pn * BM;
        if (tps) { const int t = u.pn / tps; base += (size_t)t * split_stride; colt = (u.pn - t * tps) * BM; }
        const int col0 = colt + wc * 32 + 8 * fq;
        f32x4 bv[2][2];
#pragma unroll
        for (int bj = 0; bj < 2; ++bj)
#pragma unroll
            for (int n = 0; n < 2; ++n) bv[bj][n] = bias ? *(const f32x4*)(bias + col0 + bj * HALF + 4 * n) : (f32x4){0.f, 0.f, 0.f, 0.f};
#pragma unroll
        for (int ai = 0; ai < 2; ++ai)
#pragma unroll
            for (int m = 0; m < 4; ++m) { bf16_t* rowp = base + (size_t)(row0 + ai * HALF + m * 16) * ldc + col0;
#pragma unroll
                for (int bj = 0; bj < 2; ++bj) { const f32x4 v0 = acc[ai][bj][m][0] + bv[bj][0], v1 = acc[ai][bj][m][1] + bv[bj][1];
                    u32x4 w; w.x = cvt_pk_bf16(v0[0], v0[1]); w.y = cvt_pk_bf16(v0[2], v0[3]); w.z = cvt_pk_bf16(v1[0], v1[1]); w.w = cvt_pk_bf16(v1[2], v1[3]);
                    *(u32x4*)(rowp + bj * HALF) = w; } }
    }
};
struct EpiF1 {
    static constexpr bool PERM = true, SEG = false; static constexpr int SEG0 = -1, SEG1 = -1;
    bf16_t* Gt; bf16_t* Gtc; int pn_off;
    __device__ __forceinline__ void operator()(const f32x4 (&acc)[2][2][4][2], const Unit& u, int wr, int wc, int fr, int fq) const {
        bf16_t* base; int T, b, t0;
        const int upn = u.pn + pn_off;
        if (upn < 32) { base = Gt; T = SEQ; b = upn >> 4; t0 = (upn & 15) * 256; } else { base = Gtc; T = CTXL; b = upn - 32; t0 = 0; }
        const int ld = 2 * T;
#pragma unroll
        for (int ai = 0; ai < 2; ++ai)
#pragma unroll
            for (int m = 0; m < 4; ++m) { bf16_t* rowp = base + (size_t)(b * 512 + u.pm * 128 + wr * 64 + m * 16 + fr) * ld + ai * T + t0 + wc * 32 + 8 * fq;
#pragma unroll
                for (int bj = 0; bj < 2; ++bj) { const f32x4 v0 = acc[ai][bj][m][0], v1 = acc[ai][bj][m][1];
                    u32x4 w; w.x = cvt_pk_bf16(v0[0], v0[1]); w.y = cvt_pk_bf16(v0[2], v0[3]); w.z = cvt_pk_bf16(v1[0], v1[1]); w.w = cvt_pk_bf16(v1[2], v1[3]);
                    *(u32x4*)(rowp + bj * HALF) = w; } }
    }
};
struct EpiTw {
    static constexpr bool PERM = true, SEG = false; static constexpr int SEG0 = -1, SEG1 = -1;
    bf16_t* V; const float* TW;
    __device__ __forceinline__ void operator()(const f32x4 (&acc)[2][2][4][2], const Unit& u, int wr, int wc, int fr, int fq) const {
        if (wr != 0) return;
#pragma unroll
        for (int mh = 0; mh < 2; ++mh) {
            f32x4 tw[2][2][4];
#pragma unroll
            for (int m2 = 0; m2 < 2; ++m2) { const int c = 16 * (2 * mh + m2) + fr;
#pragma unroll
                for (int bj = 0; bj < 2; ++bj) { const int r0 = u.pn * BM + bj * HALF + wc * 32 + 8 * fq, a0 = r0 & 63;
                    const f32x4* tp = (const f32x4*)(TW + (size_t)(c * 64 + a0) * 2);
                    tw[m2][bj][0] = tp[0]; tw[m2][bj][1] = tp[1]; tw[m2][bj][2] = tp[2]; tw[m2][bj][3] = tp[3]; } }
#pragma unroll
            for (int m2 = 0; m2 < 2; ++m2) { const int m = 2 * mh + m2, c = 16 * m + fr;
#pragma unroll
                for (int bj = 0; bj < 2; ++bj) { const int r0 = u.pn * BM + bj * HALF + wc * 32 + 8 * fq, nch = r0 >> 6, a0 = r0 & 63;
                    const f32x4 t0 = tw[m2][bj][0], t1 = tw[m2][bj][1], t2 = tw[m2][bj][2], t3 = tw[m2][bj][3];
                    const f32x4 ur0 = acc[0][bj][m][0], ur1 = acc[0][bj][m][1], ui0 = acc[1][bj][m][0], ui1 = acc[1][bj][m][1];
                    u32x4 w0, w1;
                    w0.x = cvt_pk_bf16(ur0[0] * t0[0] + ui0[0] * t0[1], ur0[1] * t0[2] + ui0[1] * t0[3]);
                    w0.y = cvt_pk_bf16(ur0[2] * t1[0] + ui0[2] * t1[1], ur0[3] * t1[2] + ui0[3] * t1[3]);
                    w0.z = cvt_pk_bf16(ur1[0] * t2[0] + ui1[0] * t2[1], ur1[1] * t2[2] + ui1[1] * t2[3]);
                    w0.w = cvt_pk_bf16(ur1[2] * t3[0] + ui1[2] * t3[1], ur1[3] * t3[2] + ui1[3] * t3[3]);
                    w1.x = cvt_pk_bf16(ui0[0] * t0[0] - ur0[0] * t0[1], ui0[1] * t0[2] - ur0[1] * t0[3]);
                    w1.y = cvt_pk_bf16(ui0[2] * t1[0] - ur0[2] * t1[1], ui0[3] * t1[2] - ur0[3] * t1[3]);
                    w1.z = cvt_pk_bf16(ui1[0] * t2[0] - ur1[0] * t2[1], ui1[1] * t2[2] - ur1[1] * t2[3]);
                    w1.w = cvt_pk_bf16(ui1[2] * t3[0] - ur1[2] * t3[1], ui1[3] * t3[2] - ur1[3] * t3[3]);
                    bf16_t* vp = V + ((size_t)(c * 1024 + nch) * 2) * 64 + a0;
                    *(u32x4*)vp = w0; *(u32x4*)(vp + 64) = w1; } }
            asm volatile("" ::: "memory"); }
    }
};
struct EpiFm2 {
    static constexpr bool PERM = true, SEG = false; static constexpr int SEG0 = -1, SEG1 = -1;
    bf16_t* O;
    __device__ __forceinline__ void operator()(const f32x4 (&acc)[2][2][4][2], const Unit& u, int wr, int wc, int fr, int fq) const {
        if (wr != 0) return;
        const int c = u.pn >> 2, q = u.pn & 3, bt = q >> 1, col0 = (q & 1) * 256 + wc * 32 + 8 * fq;
#pragma unroll
        for (int m = 0; m < 4; ++m) { const int d = 16 * m + fr; bf16_t* rowp = O + (size_t)(bt * SEQ + c + 64 * d) * DM + col0;
#pragma unroll
            for (int bj = 0; bj < 2; ++bj) { const f32x4 v0 = acc[0][bj][m][0], v1 = acc[0][bj][m][1];
                u32x4 w; w.x = cvt_pk_bf16(v0[0], v0[1]); w.y = cvt_pk_bf16(v0[2], v0[3]); w.z = cvt_pk_bf16(v1[0], v1[1]); w.w = cvt_pk_bf16(v1[2], v1[3]);
                *(u32x4*)(rowp + bj * HALF) = w; } }
    }
};
struct EpiMerge {
    static constexpr bool PERM = true, SEG = true; static constexpr int SEG0 = 8, SEG1 = 24;
    const bf16_t* P; bf16_t* O;
    float* slab; unsigned* cnt;
    __device__ __forceinline__ void seg(f32x4 (&acc)[2][2][4][2], const Unit& u, int t, int wr, int wc, int fr, int fq) const {
        const int gi = (t == SEG0) ? 0 : 1;
        const int col0 = u.pn * BM + wc * 32 + 8 * fq;
#pragma unroll
        for (int ai = 0; ai < 2; ++ai) {
            u32x4 za[4][2], zb[4][2];
#pragma unroll
            for (int m = 0; m < 4; ++m) { const bf16_t* prow = P + (size_t)(u.pm * BM + ai * HALF + wr * 64 + m * 16 + fr) * NINP + OFF_G + gi * DM + col0;
#pragma unroll
                for (int bj = 0; bj < 2; ++bj) { za[m][bj] = *(const u32x4*)(prow + bj * HALF); zb[m][bj] = *(const u32x4*)(prow + DM + bj * HALF); } }
#pragma unroll
            for (int m = 0; m < 4; ++m)
#pragma unroll
                for (int bj = 0; bj < 2; ++bj) { const u32x4 a = za[m][bj], b = zb[m][bj];
                    f32x4 r0, r1;
                    r0[0] = (1.f + __expf(-bflo(b.x))) * __builtin_amdgcn_rcpf(1.f + __expf(-bflo(a.x)));
                    r0[1] = (1.f + __expf(-bfhi(b.x))) * __builtin_amdgcn_rcpf(1.f + __expf(-bfhi(a.x)));
                    r0[2] = (1.f + __expf(-bflo(b.y))) * __builtin_amdgcn_rcpf(1.f + __expf(-bflo(a.y)));
                    r0[3] = (1.f + __expf(-bfhi(b.y))) * __builtin_amdgcn_rcpf(1.f + __expf(-bfhi(a.y)));
                    r1[0] = (1.f + __expf(-bflo(b.z))) * __builtin_amdgcn_rcpf(1.f + __expf(-bflo(a.z)));
                    r1[1] = (1.f + __expf(-bfhi(b.z))) * __builtin_amdgcn_rcpf(1.f + __expf(-bfhi(a.z)));
                    r1[2] = (1.f + __expf(-bflo(b.w))) * __builtin_amdgcn_rcpf(1.f + __expf(-bflo(a.w)));
                    r1[3] = (1.f + __expf(-bfhi(b.w))) * __builtin_amdgcn_rcpf(1.f + __expf(-bfhi(a.w)));
                    acc[ai][bj][m][0] *= r0; acc[ai][bj][m][1] *= r1; }
            asm volatile("" ::: "memory");
        }
    }
    __device__ __forceinline__ void operator()(const f32x4 (&acc)[2][2][4][2], const Unit& u, int wr, int wc, int fr, int fq) const {
        const int col0 = u.pn * BM + wc * 32 + 8 * fq;
        if (u.ks >= 0) {
            const int seg = (u.ks == 0) ? 0 : (u.ks == 3 ? 2 : 1);
#pragma unroll
            for (int ai = 0; ai < 2; ++ai) {
                u32x4 zz[4][2];
#pragma unroll
                for (int m = 0; m < 4; ++m) { const size_t row = (size_t)(u.pm * BM + ai * HALF + wr * 64 + m * 16 + fr);
#pragma unroll
                    for (int bj = 0; bj < 2; ++bj) zz[m][bj] = *(const u32x4*)(P + row * NINP + OFF_G + seg * DM + col0 + bj * HALF); }
#pragma unroll
                for (int m = 0; m < 4; ++m) { const size_t row = (size_t)(u.pm * BM + ai * HALF + wr * 64 + m * 16 + fr);
#pragma unroll
                    for (int bj = 0; bj < 2; ++bj) {
                        const int c = col0 + bj * HALF; const u32x4 z = zz[m][bj];
                        f32x4 v0 = acc[ai][bj][m][0], v1 = acc[ai][bj][m][1];
                        v0[0] *= sigmoidf_(bflo(z.x)); v0[1] *= sigmoidf_(bfhi(z.x)); v0[2] *= sigmoidf_(bflo(z.y)); v0[3] *= sigmoidf_(bfhi(z.y));
                        v1[0] *= sigmoidf_(bflo(z.z)); v1[1] *= sigmoidf_(bfhi(z.z)); v1[2] *= sigmoidf_(bflo(z.w)); v1[3] *= sigmoidf_(bfhi(z.w));
                        float* sp = slab + ((size_t)u.ks * MC + (row - ML)) * DM + c;
                        *(f32x4*)sp = v0; *(f32x4*)(sp + 4) = v1;
                    } }
                asm volatile("" ::: "memory");
            }
            asm volatile("s_waitcnt vmcnt(0)" ::: "memory");
            __builtin_amdgcn_fence(__ATOMIC_RELEASE, "agent");
            asm volatile("s_waitcnt vmcnt(0)" ::: "memory");
            unsigned old = 0;
            if (fr == 0 && fq == 0) old = __hip_atomic_fetch_add(cnt + ((u.pm - 32) * 8 + u.pn) * 8 + wr * 4 + wc, 1u, __ATOMIC_RELAXED, __HIP_MEMORY_SCOPE_AGENT);
            old = (unsigned)__builtin_amdgcn_readfirstlane((int)old);
            if (old == 3u) {
                __builtin_amdgcn_fence(__ATOMIC_ACQUIRE, "agent");
                asm volatile("s_waitcnt vmcnt(0)" ::: "memory");
#pragma unroll
                for (int ai = 0; ai < 2; ++ai)
#pragma unroll
                    for (int mh = 0; mh < 2; ++mh) {
                        f32x4 sv[2][2][4][2];
#pragma unroll
                        for (int m2 = 0; m2 < 2; ++m2) { const size_t row = (size_t)(u.pm * BM + ai * HALF + wr * 64 + (2 * mh + m2) * 16 + fr);
#pragma unroll
                            for (int bj = 0; bj < 2; ++bj) { const float* sp = slab + (size_t)(row - ML) * DM + col0 + bj * HALF;
#pragma unroll
                                for (int k2 = 0; k2 < 4; ++k2) { sv[m2][bj][k2][0] = *(const f32x4*)(sp + (size_t)k2 * MC * DM); sv[m2][bj][k2][1] = *(const f32x4*)(sp + (size_t)k2 * MC * DM + 4); } } }
#pragma unroll
                        for (int m2 = 0; m2 < 2; ++m2) { const size_t row = (size_t)(u.pm * BM + ai * HALF + wr * 64 + (2 * mh + m2) * 16 + fr);
#pragma unroll
                            for (int bj = 0; bj < 2; ++bj) {
                                const f32x4 v0 = (sv[m2][bj][0][0] + sv[m2][bj][1][0]) + (sv[m2][bj][2][0] + sv[m2][bj][3][0]), v1 = (sv[m2][bj][0][1] + sv[m2][bj][1][1]) + (sv[m2][bj][2][1] + sv[m2][bj][3][1]);
                                u32x4 w; w.x = cvt_pk_bf16(v0[0], v0[1]); w.y = cvt_pk_bf16(v0[2], v0[3]); w.z = cvt_pk_bf16(v1[0], v1[1]); w.w = cvt_pk_bf16(v1[2], v1[3]);
                                *(u32x4*)(O + row * DM + col0 + bj * HALF) = w; } }
                        asm volatile("" ::: "memory");
                    }
            }
            return;
        }
#pragma unroll
        for (int ai = 0; ai < 2; ++ai) {
            u32x4 zz[4][2];
#pragma unroll
            for (int m = 0; m < 4; ++m) { const size_t row = (size_t)(u.pm * BM + ai * HALF + wr * 64 + m * 16 + fr);
#pragma unroll
                for (int bj = 0; bj < 2; ++bj) zz[m][bj] = *(const u32x4*)(P + row * NINP + OFF_G + 2 * DM + col0 + bj * HALF); }
#pragma unroll
            for (int m = 0; m < 4; ++m) { const size_t row = (size_t)(u.pm * BM + ai * HALF + wr * 64 + m * 16 + fr);
#pragma unroll
                for (int bj = 0; bj < 2; ++bj) {
                    const int c = col0 + bj * HALF; const u32x4 z = zz[m][bj];
                    const f32x4 v0 = acc[ai][bj][m][0], v1 = acc[ai][bj][m][1];
                    u32x4 w;
                    w.x = cvt_pk_bf16(v0[0] * sigmoidf_(bflo(z.x)), v0[1] * sigmoidf_(bfhi(z.x)));
                    w.y = cvt_pk_bf16(v0[2] * sigmoidf_(bflo(z.y)), v0[3] * sigmoidf_(bfhi(z.y)));
                    w.z = cvt_pk_bf16(v1[0] * sigmoidf_(bflo(z.z)), v1[1] * sigmoidf_(bfhi(z.z)));
                    w.w = cvt_pk_bf16(v1[2] * sigmoidf_(bflo(z.w)), v1[3] * sigmoidf_(bfhi(z.w)));
                    *(u32x4*)(O + row * DM + c) = w;
                } }
            asm volatile("" ::: "memory");
        }
    }
};
template <bool RB, bool OB>
struct EpiResid {
    static constexpr bool PERM = true, SEG = false; static constexpr int SEG0 = -1, SEG1 = -1;
    const void* res_lat; const void* res_ctx; void* out_lat; void* out_ctx; const float* gate;
    float* slab;
    __device__ __forceinline__ void operator()(const f32x4 (&acc)[2][2][4][2], const Unit& u, int wr, int wc, int fr, int fq) const {
        if (u.ks >= 0) {
            float* sb = slab + ((size_t)u.ks * MC + (size_t)(u.pm - 32) * BM) * DM + u.pn * BM + wc * 32 + 8 * fq;
#pragma unroll
            for (int ai = 0; ai < 2; ++ai)
#pragma unroll
                for (int m = 0; m < 4; ++m) { float* rp = sb + (size_t)(ai * HALF + wr * 64 + m * 16 + fr) * DM;
#pragma unroll
                    for (int bj = 0; bj < 2; ++bj) { *(f32x4*)(rp + bj * HALF) = acc[ai][bj][m][0]; *(f32x4*)(rp + bj * HALF + 4) = acc[ai][bj][m][1]; } }
            return;
        }
        const int s = u.pm < 16 ? 0 : (u.pm < 32 ? 1 : 2);
        const size_t tile0 = (size_t)(u.pm < 32 ? u.pm : u.pm - 32) * BM * DM;
        const void* resv = u.pm < 32 ? res_lat : res_ctx; void* outv = u.pm < 32 ? out_lat : out_ctx;
        const int col0 = u.pn * BM + wc * 32 + 8 * fq;
        f32x4 gv[2][2];
#pragma unroll
        for (int bj = 0; bj < 2; ++bj)
#pragma unroll
            for (int n = 0; n < 2; ++n) gv[bj][n] = *(const f32x4*)(gate + s * 12288 + col0 + bj * HALF + 4 * n);
#pragma unroll
        for (int ai = 0; ai < 2; ++ai) {
            f32x4 r[4][2][2];
#pragma unroll
            for (int m = 0; m < 4; ++m) { const size_t off = tile0 + (size_t)(ai * HALF + wr * 64 + m * 16 + fr) * DM + col0;
#pragma unroll
                for (int bj = 0; bj < 2; ++bj) {
                    if constexpr (RB) { const u32x4 w = *(const u32x4*)((const bf16_t*)resv + off + bj * HALF);
                        r[m][bj][0] = (f32x4){bflo(w.x), bfhi(w.x), bflo(w.y), bfhi(w.y)}; r[m][bj][1] = (f32x4){bflo(w.z), bfhi(w.z), bflo(w.w), bfhi(w.w)}; }
                    else { r[m][bj][0] = *(const f32x4*)((const float*)resv + off + bj * HALF); r[m][bj][1] = *(const f32x4*)((const float*)resv + off + bj * HALF + 4); } } }
#pragma unroll
            for (int m = 0; m < 4; ++m) { const size_t off = tile0 + (size_t)(ai * HALF + wr * 64 + m * 16 + fr) * DM + col0;
#pragma unroll
                for (int bj = 0; bj < 2; ++bj) { const f32x4 v0 = r[m][bj][0] + gv[bj][0] * acc[ai][bj][m][0], v1 = r[m][bj][1] + gv[bj][1] * acc[ai][bj][m][1];
                    if constexpr (OB) { u32x4 w; w.x = cvt_pk_bf16(v0[0], v0[1]); w.y = cvt_pk_bf16(v0[2], v0[3]); w.z = cvt_pk_bf16(v1[0], v1[1]); w.w = cvt_pk_bf16(v1[2], v1[3]);
                        *(u32x4*)((bf16_t*)outv + off + bj * HALF) = w; }
                    else { *(f32x4*)((float*)outv + off + bj * HALF) = v0; *(f32x4*)((float*)outv + off + bj * HALF + 4) = v1; } } }
            asm volatile("" ::: "memory"); }
    }
};
struct EpiSwiglu {
    static constexpr bool PERM = true, SEG = false; static constexpr int SEG0 = -1, SEG1 = -1;
    bf16_t* T;
    __device__ __forceinline__ void operator()(const f32x4 (&acc)[2][2][4][2], const Unit& u, int wr, int wc, int fr, int fq) const {
        const int col0 = u.pn * HALF + wc * 32 + 8 * fq;
#pragma unroll
        for (int ai = 0; ai < 2; ++ai)
#pragma unroll
            for (int m = 0; m < 4; ++m) { bf16_t* rowp = T + (size_t)(u.pm * BM + ai * HALF + wr * 64 + m * 16 + fr) * DFF + col0;
                f32x4 o0, o1;
#pragma unroll
                for (int j = 0; j < 4; ++j) { const float g0 = acc[ai][0][m][0][j], g1 = acc[ai][0][m][1][j];
                    o0[j] = g0 * sigmoidf_(g0) * acc[ai][1][m][0][j]; o1[j] = g1 * sigmoidf_(g1) * acc[ai][1][m][1][j]; }
                u32x4 w; w.x = cvt_pk_bf16(o0[0], o0[1]); w.y = cvt_pk_bf16(o0[2], o0[3]); w.z = cvt_pk_bf16(o1[0], o1[1]); w.w = cvt_pk_bf16(o1[2], o1[3]);
                *(u32x4*)rowp = w; }
    }
};
}

namespace at {
constexpr int DQ = 192, DV = 128, NW = 8, QBLK = 32, KVBLK = 64;
constexpr float SCALE = 0.07216878364870322f;
constexpr float THR = 8.f;
#ifndef QKT_GRP
#define QKT_GRP 12
#endif
constexpr size_t SHM_V = KVBLK * DV * 2, SHM_K = KVBLK * DQ * 2, SHM_ATTN = 2 * SHM_V + 2 * SHM_K + NW * 64 * 4;
#define KSWZ(row, colB) ((row) * 384 + ((colB) ^ ((((row) >> 1) & 7) << 4)))
#define SBAR() __builtin_amdgcn_sched_barrier(0)
__device__ __forceinline__ int crow(int r, int hi) { return (r & 3) + 8 * (r >> 2) + 4 * hi; }
__device__ __forceinline__ void partialSM(f32x16& p0, f32x16& p1, float& m_reg, float& mn, float& alpha) {
    constexpr float C = SCALE * 1.4426950408889634f;
    float pmax = p0[0];
#pragma unroll
    for (int r = 1; r < 16; ++r) pmax = fmaxf(pmax, p0[r]);
#pragma unroll
    for (int r = 0; r < 16; ++r) pmax = fmaxf(pmax, p1[r]);
    { auto rr = __builtin_amdgcn_permlane32_swap(__float_as_uint(pmax), __float_as_uint(pmax), false, false);
      pmax = fmaxf(__uint_as_float(rr[0]), __uint_as_float(rr[1])); }
    if (__builtin_expect(__all(pmax - m_reg <= THR / SCALE), 1)) { mn = m_reg; alpha = 1.f; }
    else { mn = fmaxf(m_reg, pmax); alpha = __builtin_amdgcn_exp2f((m_reg - mn) * C); m_reg = mn; }
    const float mnC = -mn * C;
#pragma unroll
    for (int r = 0; r < 16; ++r) p0[r] = fmaf(p0[r], C, mnC);
#pragma unroll
    for (int r = 0; r < 16; ++r) p1[r] = fmaf(p1[r], C, mnC);
#pragma unroll
    for (int r = 0; r < 16; ++r) p0[r] = __builtin_amdgcn_exp2f(p0[r]);
}
__device__ __forceinline__ void finishSM(f32x16& p0, f32x16& p1, float alpha, float& l_reg, bf16x8& pa0, bf16x8& pa1, bf16x8& pa2, bf16x8& pa3) {
#pragma unroll
    for (int r = 0; r < 16; ++r) p1[r] = __builtin_amdgcn_exp2f(p1[r]);
    float ps = 0;
#pragma unroll
    for (int r = 0; r < 16; ++r) ps += p0[r];
#pragma unroll
    for (int r = 0; r < 16; ++r) ps += p1[r];
    { auto rr = __builtin_amdgcn_permlane32_swap(__float_as_uint(ps), __float_as_uint(ps), false, false);
      ps = __uint_as_float(rr[0]) + __uint_as_float(rr[1]); }
    l_reg = l_reg * alpha + ps;
#define PK4(P, BASE, OUT) do { unsigned a0 = cvt_pk_bf16(P[BASE + 0], P[BASE + 1]), a1 = cvt_pk_bf16(P[BASE + 2], P[BASE + 3]);   \
    unsigned b0 = cvt_pk_bf16(P[BASE + 4], P[BASE + 5]), b1 = cvt_pk_bf16(P[BASE + 6], P[BASE + 7]);                              \
    auto r0 = __builtin_amdgcn_permlane32_swap(a0, b0, false, false); auto r1 = __builtin_amdgcn_permlane32_swap(a1, b1, false, false); \
    u32x4 w = {r0[0], r1[0], r0[1], r1[1]}; OUT = *reinterpret_cast<bf16x8*>(&w); } while (0)
    PK4(p0, 0, pa0); PK4(p0, 8, pa1); PK4(p1, 0, pa2); PK4(p1, 8, pa3);
#undef PK4
}
__device__ __forceinline__ void qkt(f32x16& p0, f32x16& p1, const char* Ks, const bf16x8* qr, int wv) {
    p0 = f32x16{}; p1 = f32x16{};
    const int l_ = TID(wv) & 63, r32 = l_ & 31, hi = l_ >> 5;
    const int sw = ((r32 >> 1) & 7) << 4, rb = r32 * 384;
    const char* kb[4];
#pragma unroll
    for (int i = 0; i < 4; ++i) kb[i] = Ks + rb + ((i * 32 + hi * 16) ^ sw);
#pragma unroll
    for (int d0 = 0; d0 < 12; ++d0) {
        const bf16x8 b0 = *reinterpret_cast<const bf16x8*>(kb[d0 & 3] + (d0 >> 2) * 128);
        const bf16x8 b1 = *reinterpret_cast<const bf16x8*>(kb[d0 & 3] + (d0 >> 2) * 128 + 32 * 384);
        p0 = __builtin_amdgcn_mfma_f32_32x32x16_bf16(b0, qr[d0], p0, 0, 0, 0);
        p1 = __builtin_amdgcn_mfma_f32_32x32x16_bf16(b1, qr[d0], p1, 0, 0, 0); }
}
__device__ __forceinline__ int v_st(int k, int c) { const int kk = (k & ~0xC) | ((k & 4) << 1) | ((k & 8) >> 1); return ((kk >> 3) * 4 + (c >> 5)) * 512 + ((kk & 7) * 32 + (c & 31)) * 2; }
__device__ __forceinline__ int v_rd_base(int lane) { return ((lane & 3) << 3) | (((lane >> 2) & 3) << 6) | (((lane >> 4) & 1) << 5) | (((lane >> 5) & 1) << 8); }
constexpr int v_rd_off(int d0, int ks, int half) { return d0 * 512 + ks * 4096 + half * 2048; }
template <int OFF> __device__ __forceinline__ s16x4 tr_read(int vb) {
    s16x4 r; asm volatile("ds_read_b64_tr_b16 %0, %1 offset:%2" : "=&v"(r) : "v"(vb), "i"(OFF) : "memory"); return r;
}
template <int D0> __device__ __forceinline__ void pv_one(f32x16& od, int vb, bf16x8 pa0, bf16x8 pa1, bf16x8 pa2, bf16x8 pa3) {
    const s16x4 l0 = tr_read<v_rd_off(D0, 0, 0)>(vb), h0 = tr_read<v_rd_off(D0, 0, 1)>(vb), l1 = tr_read<v_rd_off(D0, 1, 0)>(vb), h1 = tr_read<v_rd_off(D0, 1, 1)>(vb);
    const s16x4 l2 = tr_read<v_rd_off(D0, 2, 0)>(vb), h2 = tr_read<v_rd_off(D0, 2, 1)>(vb), l3 = tr_read<v_rd_off(D0, 3, 0)>(vb), h3 = tr_read<v_rd_off(D0, 3, 1)>(vb);
    asm volatile("s_waitcnt lgkmcnt(0)" ::: "memory"); SBAR();
#define PK(L, H) (bf16x8){L[0], L[1], L[2], L[3], H[0], H[1], H[2], H[3]}
    od = __builtin_amdgcn_mfma_f32_32x32x16_bf16(pa0, PK(l0, h0), od, 0, 0, 0);
    od = __builtin_amdgcn_mfma_f32_32x32x16_bf16(pa1, PK(l1, h1), od, 0, 0, 0);
    od = __builtin_amdgcn_mfma_f32_32x32x16_bf16(pa2, PK(l2, h2), od, 0, 0, 0);
    od = __builtin_amdgcn_mfma_f32_32x32x16_bf16(pa3, PK(l3, h3), od, 0, 0, 0);
#undef PK
}
__device__ __forceinline__ void pv_d0(f32x16* o, int vb, bf16x8 pa0, bf16x8 pa1, bf16x8 pa2, bf16x8 pa3) {
    pv_one<0>(o[0], vb, pa0, pa1, pa2, pa3); pv_one<1>(o[1], vb, pa0, pa1, pa2, pa3); pv_one<2>(o[2], vb, pa0, pa1, pa2, pa3); pv_one<3>(o[3], vb, pa0, pa1, pa2, pa3);
}
constexpr size_t SHM_ATTN2 = 3 * SHM_V + 2 * SHM_K + NW * 64 * 4;
__device__ __forceinline__ void attn_body(const bf16_t* __restrict__ Qb, const bf16_t* __restrict__ Kh, const bf16_t* __restrict__ Vh,
                                          bf16_t* __restrict__ Ob, int ldo, int seq, char* lds, int wv) {
    const int tid = TID(wv), wid = tid >> 6, lane = tid & 63, r32 = lane & 31, hi = lane >> 5;
    char* V_lds = lds; char* K_lds = lds + 3 * SHM_V;
    float* wsf = (float*)(lds + 3 * SHM_V + 2 * SHM_K) + wid * 64; float* li_l = wsf; float* al_l = wsf + 32;
    LAS unsigned char* ldsl = (LAS unsigned char*)(unsigned)(uintptr_t)lds;
    float m_reg = -1e30f, l_reg = 0; f32x16 o[4] = {}; bf16x8 qr[12];
    const bf16_t* Qw = Qb + (long)(wid * QBLK + r32) * DQ + hi * 8;
#pragma unroll
    for (int d0 = 0; d0 < 12; ++d0) qr[d0] = *reinterpret_cast<const bf16x8*>(Qw + d0 * 16);
    const int vbase = (int)(uintptr_t)V_lds;
#define vb0 (vbase + v_rd_base(TID(wv) & 63))
    const unsigned ldsw = (unsigned)__builtin_amdgcn_readfirstlane(wid) * 1024u;
#define KSRC(t_, i) ({ const int _q = (i) * 512 + (t_), _row = _q / 24, _cb = (_q - _row * 24) * 16; (unsigned)(_row * 384 + (_cb ^ (((_row >> 1) & 7) << 4))); })
#define VSRC(t_, i) ({ const int _ob = ((i) * 512 + (t_)) * 16, _sub = _ob >> 9, _w = _ob & 511, _kk = (_sub >> 2) * 8 + (_w >> 6), _c = (_sub & 3) * 32 + ((_w >> 1) & 31); \
    const int _k = (_kk & ~0xC) | ((_kk & 4) << 1) | ((_kk & 8) >> 1); (unsigned)(_k * 256 + _c * 2); })
#define GLDS_TILE(t, kb, vbuf) do { const int t_ = TID(wv); const char* _kp = (const char*)Kh + (size_t)(t) * (KVBLK * DQ * 2); const char* _vp = (const char*)Vh + (size_t)(t) * (KVBLK * DV * 2); \
    _Pragma("unroll") for (int _i = 0; _i < 3; ++_i) __builtin_amdgcn_global_load_lds((const unsigned*)(_kp + KSRC(t_, _i)), (LAS unsigned*)(ldsl + 3 * SHM_V + (kb) * SHM_K + _i * 8192 + ldsw), 16, 0, 0); \
    _Pragma("unroll") for (int _i = 0; _i < 2; ++_i) __builtin_amdgcn_global_load_lds((const unsigned*)(_vp + VSRC(t_, _i)), (LAS unsigned*)(ldsl + (vbuf) + _i * 8192 + ldsw), 16, 0, 0); } while (0)
#define TSYNC() do { asm volatile("s_waitcnt vmcnt(0)" ::: "memory"); __syncthreads(); } while (0)
#define RESC(a) do { if (__any((a) < 1.f)) { if (hi == 0) al_l[r32] = (a); asm volatile("s_waitcnt lgkmcnt(0)" ::: "memory"); \
    _Pragma("unroll") for (int d = 0; d < 4; ++d) _Pragma("unroll") for (int r = 0; r < 16; ++r) o[d][r] *= al_l[crow(r, hi)]; } } while (0)
    f32x16 pA0, pA1, pB0, pB1; float mnA, mnB, alA, alB; bf16x8 pa0, pa1, pa2, pa3; const int NT = seq / KVBLK;
    GLDS_TILE(0, 0, 0); TSYNC();
    GLDS_TILE(1, 1, (int)SHM_V);
    qkt(pA0, pA1, K_lds, qr, wv); partialSM(pA0, pA1, m_reg, mnA, alA);
    TSYNC();
    int vprev = 0, vcur = (int)SHM_V, vnext = 2 * (int)SHM_V;
    for (int j = 1; j + 1 < NT; j += 2) {
        GLDS_TILE(j + 1, 0, vnext);
        SBAR(); qkt(pB0, pB1, K_lds + SHM_K, qr, wv);
        finishSM(pA0, pA1, alA, l_reg, pa0, pa1, pa2, pa3); SBAR();
        pv_d0(o, vb0 + vprev, pa0, pa1, pa2, pa3); partialSM(pB0, pB1, m_reg, mnB, alB);
        TSYNC(); RESC(alB);
        GLDS_TILE(j + 2, 1, vprev);
        SBAR(); qkt(pA0, pA1, K_lds, qr, wv);
        finishSM(pB0, pB1, alB, l_reg, pa0, pa1, pa2, pa3); SBAR();
        pv_d0(o, vb0 + vcur, pa0, pa1, pa2, pa3); partialSM(pA0, pA1, m_reg, mnA, alA);
        TSYNC(); RESC(alA);
        { const int t0 = vprev; vprev = vnext; vnext = vcur; vcur = t0; }
    }
    SBAR(); qkt(pB0, pB1, K_lds + SHM_K, qr, wv);
    finishSM(pA0, pA1, alA, l_reg, pa0, pa1, pa2, pa3); SBAR();
    pv_d0(o, vb0 + vprev, pa0, pa1, pa2, pa3); partialSM(pB0, pB1, m_reg, mnB, alB);
    RESC(alB);
    finishSM(pB0, pB1, alB, l_reg, pa0, pa1, pa2, pa3); SBAR();
    pv_d0(o, vb0 + vcur, pa0, pa1, pa2, pa3);
    if (hi == 0) li_l[r32] = l_reg; asm volatile("s_waitcnt lgkmcnt(0)" ::: "memory");
    float rli[16];
#pragma unroll
    for (int r = 0; r < 16; ++r) rli[r] = __builtin_amdgcn_rcpf(li_l[crow(r, hi)]);
    bf16_t* Ow = Ob + (long)(wid * QBLK) * ldo;
#pragma unroll
    for (int r = 0; r < 16; ++r) { const int orow = crow(r, hi);
#pragma unroll
        for (int d0 = 0; d0 < 4; ++d0) Ow[(long)orow * ldo + d0 * 32 + r32] = f2bf(o[d0][r] * rli[r]); }
#undef vb0
#undef GLDS_TILE
#undef KSRC
#undef VSRC
#undef TSYNC
#undef RESC
}
}

constexpr int NT_ = 512;

__device__ void adaln_phase(const Params& P, int wv) {
    float* mod = (float*)(P.ws + WS_MOD);
    const float* c = P.in[I_C]; const float* cc = P.in[I_CCTX];
    const int tid = TID(wv), lane = tid & 63, kk = lane >> 2, c4 = lane & 3;
    const int gwv = BID() * 8 + (tid >> 6), nwv = GDIM() * 8;
    for (int item = gwv; item < 2 * 768; item += nwv) {
        const int l = item / 768, col = (item % 768) * 16 + c4 * 4;
        const float* W = P.in[I_WADA] + (size_t)l * DM * 12288 + col;
        f32x4 a0 = {0, 0, 0, 0}, a1 = a0, a2 = a0;
#pragma unroll 8
        for (int i = 0; i < 128; ++i) {
            const int k = kk + 16 * i;
            const f32x4 w = *(const f32x4*)(W + (size_t)k * 12288);
            float x0 = c[k], x1 = c[DM + k], x2 = cc[k];
            x0 = x0 * sigmoidf_(x0); x1 = x1 * sigmoidf_(x1); x2 = x2 * sigmoidf_(x2);
            a0 += x0 * w; a1 += x1 * w; a2 += x2 * w;
        }
#pragma unroll
        for (int o = 4; o <= 32; o <<= 1)
#pragma unroll
            for (int j = 0; j < 4; ++j) { a0[j] += __shfl_xor(a0[j], o); a1[j] += __shfl_xor(a1[j], o); a2[j] += __shfl_xor(a2[j], o); }
        if (kk == 0) {
            const f32x4 bsv = *(const f32x4*)(P.in[I_BADA] + l * 12288 + col);
            float* m0 = mod + (size_t)(l * 3) * 12288 + col;
            *(f32x4*)m0 = a0 + bsv; *(f32x4*)(m0 + 12288) = a1 + bsv; *(f32x4*)(m0 + 2 * 12288) = a2 + bsv;
        }
    }
}

__device__ void dft_phase(const Params& P, int wv) {
    bf16_t* Bd = (bf16_t*)(P.ws + WS_BD); bf16_t* A2c = (bf16_t*)(P.ws + WS_A2C);
    const int gt = BID() * NT_ + TID(wv), gs = GDIM() * NT_;
    for (int id = gt; id < 1024 * 64; id += gs) {
        const int m = id >> 6, k0 = (id & 63) * 8, g = m >> 8, ri = (m >> 7) & 1, cidx = m & 127;
        float v[8];
#pragma unroll
        for (int e = 0; e < 8; ++e) { const int k = k0 + e, g2 = k >> 7, c2 = k & 127; const float fr = (float)((cidx * c2) & 127) * (1.0f / 128.0f);
            const float t = ri ? -__builtin_amdgcn_sinf(fr) : __builtin_amdgcn_cosf(fr); v[e] = (g2 == g) ? t * 0.08838834764831845f : 0.f; }
        u32x4 w = {cvt_pk_bf16(v[0], v[1]), cvt_pk_bf16(v[2], v[3]), cvt_pk_bf16(v[4], v[5]), cvt_pk_bf16(v[6], v[7])};
        *(u32x4*)(Bd + (size_t)m * 512 + k0) = w;
    }
    { float* RT = (float*)(P.ws + WS_ROPE);
      for (int id = gt; id < SEQ * 32; id += gs) { const int t = id >> 5, i = id & 31; const float invf = __builtin_amdgcn_exp2f(-(float)(i & 15) * (13.287712379549449f / 16.0f));
        const float ang = (float)((i < 16) ? (t >> 6) : (t & 63)) * invf, rev = ang * 0.15915494309189535f, fr = rev - floorf(rev);
        RT[id * 2] = __builtin_amdgcn_cosf(fr); RT[id * 2 + 1] = __builtin_amdgcn_sinf(fr); } }
    { float* TW = (float*)(P.ws + WS_TW);
      for (int id = gt; id < 64 * 64; id += gs) { const int c = id >> 6, a = id & 63; const float ph = (float)(c * a) * (1.0f / 4096.0f);
        TW[id * 2] = __builtin_amdgcn_cosf(ph); TW[id * 2 + 1] = __builtin_amdgcn_sinf(ph); } }
    { bf16_t* DB = (bf16_t*)(P.ws + WS_DB); bf16_t* DC = (bf16_t*)(P.ws + WS_DC);
      for (int id = gt; id < 2 * 256 * 16; id += gs) {
        const int which = id >> 12, m = (id >> 4) & 255, k0 = (id & 15) * 8;
        float v[8];
#pragma unroll
        for (int e = 0; e < 8; ++e) { const int k = k0 + e, ri = k >> 6, x = k & 63; float val;
            if (which == 0) { const int ro = m >> 7, c = m & 127; const float ph = (float)((c * x) & 63) * (1.0f / 64.0f); const float cs = __builtin_amdgcn_cosf(ph), sn = __builtin_amdgcn_sinf(ph);
                val = (c < 64) ? (ro == ri ? cs : (ro == 0 ? sn : -sn)) : 0.f; }
            else { const float ph = (float)((m * x) & 63) * (1.0f / 64.0f); val = (m < 64) ? (ri ? __builtin_amdgcn_sinf(ph) : __builtin_amdgcn_cosf(ph)) * (1.0f / 64.0f) : 0.f; }
            v[e] = val; }
        u32x4 w = {cvt_pk_bf16(v[0], v[1]), cvt_pk_bf16(v[2], v[3]), cvt_pk_bf16(v[4], v[5]), cvt_pk_bf16(v[6], v[7])};
        *(u32x4*)((which ? DC : DB) + (size_t)m * 128 + k0) = w; } }
    for (int id = gt; id < 256 * 64; id += gs) {
        const int t = id >> 6, k0 = (id & 63) * 8, ri = k0 >> 8;
        float v[8];
#pragma unroll
        for (int e = 0; e < 8; ++e) { const int tp = (k0 + e) & 255; const float fr = (float)((t * tp) & 255) * (1.0f / 256.0f);
            v[e] = (ri ? __builtin_amdgcn_sinf(fr) : __builtin_amdgcn_cosf(fr)) * (1.0f / 16.0f); }
        u32x4 w = {cvt_pk_bf16(v[0], v[1]), cvt_pk_bf16(v[2], v[3]), cvt_pk_bf16(v[4], v[5]), cvt_pk_bf16(v[6], v[7])};
        *(u32x4*)(A2c + (size_t)t * 512 + k0) = w;
    }
}

struct WJob { const float* src; bf16_t* dst; const float* scale; int K, N, ldd, koff, nmode; };
__device__ __forceinline__ WJob get_wjob(int mi, const Params& P, int l) {
    WJob j; j.scale = nullptr; j.koff = 0; j.nmode = 0;
    unsigned char* ws = P.ws;
    switch (mi) {
    case 0: j.src = P.in[I_WIN] + (size_t)l * DM * NIN; j.dst = (bf16_t*)(ws + WS_WIN); j.K = DM; j.N = NIN; j.ldd = DM; break;
    case 1: j.src = P.in[I_WUQ] + (size_t)l * 512 * 1536; j.dst = (bf16_t*)(ws + WS_WUQ); j.K = 512; j.N = 1536; j.ldd = 512; j.scale = P.in[I_QAN] + l * 512; break;
    case 2: j.src = P.in[I_WUKV] + (size_t)l * 256 * 2048; j.dst = (bf16_t*)(ws + WS_WUKV); j.K = 256; j.N = 2048; j.ldd = 256; j.scale = P.in[I_KVAN] + l * 256; break;
    case 3: j.src = P.in[I_WF] + (size_t)l * 512 * DM; j.dst = (bf16_t*)(ws + WS_WMG); j.K = 512; j.N = DM; j.ldd = DM; j.koff = 0; break;
    case 4: j.src = P.in[I_WMLA] + (size_t)l * 1024 * DM; j.dst = (bf16_t*)(ws + WS_WMG); j.K = 1024; j.N = DM; j.ldd = DM; j.koff = 512; break;
    case 5: j.src = P.in[I_WCONV] + (size_t)l * 512 * DM; j.dst = (bf16_t*)(ws + WS_WMG); j.K = 512; j.N = DM; j.ldd = DM; j.koff = 1536; break;
    case 6: j.src = P.in[I_WOUT] + (size_t)l * DM * DM; j.dst = (bf16_t*)(ws + WS_WOUT); j.K = DM; j.N = DM; j.ldd = DM; break;
    case 7: j.src = P.in[I_WG] + (size_t)l * DM * DFF; j.dst = (bf16_t*)(ws + WS_WGU); j.K = DM; j.N = DFF; j.ldd = DM; j.nmode = 1; break;
    case 8: j.src = P.in[I_WU] + (size_t)l * DM * DFF; j.dst = (bf16_t*)(ws + WS_WGU); j.K = DM; j.N = DFF; j.ldd = DM; j.nmode = 2; break;
    default: j.src = P.in[I_WDN] + (size_t)l * DFF * DM; j.dst = (bf16_t*)(ws + WS_WD); j.K = DFF; j.N = DM; j.ldd = DFF; break;
    }
    return j;
}
__device__ void wprep_phase(const Params& P, int l, unsigned char* lds_generic, int wv) {
    float* tile = (float*)lds_generic;
    const int tid = TID(wv), G = GDIM(), bid = BID();
    int base = 0;
#pragma unroll
    for (int mi = 0; mi < 10; ++mi) {
        const WJob j = get_wjob(mi, P, l);
        const int nkt = j.K / 64, nnt = j.N / 64, ngn = (nnt + 3) / 4, ngroups = nkt * ngn;
        int start = (bid - base % G + G) % G;
#define WLOAD(dst, grp_) do { const int _kt = (grp_) / ngn, _ng = (grp_) % ngn, _k0 = _kt * 64; \
            _Pragma("unroll") for (int q = 0; q < 4; ++q) { const int ntile = _ng * 4 + q; const bool ok = ntile < nnt; \
                _Pragma("unroll") for (int i = 0; i < 2; ++i) { const int kr = (tid >> 4) + 32 * i; dst[q][i] = ok ? *(const f32x4*)(j.src + (size_t)(_k0 + kr) * j.N + ntile * 64 + (tid & 15) * 4) : (f32x4){0, 0, 0, 0}; } } } while (0)
        f32x4 vn[4][2];
        if (start < ngroups) WLOAD(vn, start);
        for (int grp = start; grp < ngroups; grp += G) {
            const int kt = grp / ngn, ng = grp % ngn, k0 = kt * 64;
            f32x4 v[4][2];
#pragma unroll
            for (int q = 0; q < 4; ++q) { v[q][0] = vn[q][0]; v[q][1] = vn[q][1]; }
            if (grp + G < ngroups) WLOAD(vn, grp + G);
            __syncthreads();
#pragma unroll
            for (int q = 0; q < 4; ++q)
#pragma unroll
                for (int i = 0; i < 2; ++i) { const int kr = (tid >> 4) + 32 * i; float* tp = tile + (q * 64 + kr) * 65 + (tid & 15) * 4;
                    tp[0] = v[q][i][0]; tp[1] = v[q][i][1]; tp[2] = v[q][i][2]; tp[3] = v[q][i][3]; }
            __syncthreads();
            const int nl = tid >> 3, kc = (tid & 7) * 8;
            float sc[8];
#pragma unroll
            for (int e = 0; e < 8; ++e) sc[e] = j.scale ? j.scale[k0 + kc + e] : 1.f;
#pragma unroll
            for (int q = 0; q < 4; ++q) { const int ntile = ng * 4 + q; if (ntile < nnt) {
                float x[8];
#pragma unroll
                for (int e = 0; e < 8; ++e) x[e] = tile[(q * 64 + kc + e) * 65 + nl] * sc[e];
                const int n = ntile * 64 + nl;
                const int nd = j.nmode == 0 ? n : ((n >> 7) * 256 + (n & 127) + (j.nmode == 2 ? 128 : 0));
                u32x4 w = {cvt_pk_bf16(x[0], x[1]), cvt_pk_bf16(x[2], x[3]), cvt_pk_bf16(x[4], x[5]), cvt_pk_bf16(x[6], x[7])};
                *(u32x4*)(j.dst + (size_t)nd * j.ldd + j.koff + k0 + kc) = w; } }
        }
#undef WLOAD
        base += ngroups;
    }
    __syncthreads();
    { float* bp = (float*)(P.ws + WS_BIAS); const float* bgt = P.in[I_BGATE] + l * 3 * DM;
      for (int id = bid * NT_ + tid; id < NINP; id += G * NT_) bp[id] = (id >= OFF_G && id < NIN) ? bgt[id - OFF_G] : 0.f; }
    { bf16_t* W = (bf16_t*)(P.ws + WS_WIN) + (size_t)NIN * DM; const int n16 = (NINP - NIN) * DM / 8;
      for (int id = bid * NT_ + tid; id < n16; id += G * NT_) *(u32x4*)(W + (size_t)id * 8) = (u32x4){0, 0, 0, 0}; }
}

template <bool LB, bool CB>
__device__ __forceinline__ void norm_phase(const void* src_lat, const void* src_ctx, int nrows, const float* gain, const float* mod, int jshift, bf16_t* h, int wv,
                           const float* slab = nullptr, int nsplit = 0, const float* sgate = nullptr, bf16_t* xout = nullptr) {
    const int tid = TID(wv), lane = tid & 63, gw = BID() * 8 + (tid >> 6), nw = GDIM() * 8;
    u32x4 rb[4]; f32x4 rf[4][2];
#define NP_ROWMAP(r0) ((slab != nullptr) ? ((r0) + MC < nrows ? (r0) + MC : (r0) + MC - nrows + ML - (nrows - MC)) : (r0))
#define NP_LOAD(row_) do { \
        if ((row_) < ML) { _Pragma("unroll") for (int i = 0; i < 4; ++i) { const int col = (lane + 64 * i) * 8; \
            if constexpr (LB) rb[i] = *(const u32x4*)((const bf16_t*)src_lat + (size_t)(row_) * DM + col); \
            else { const float* xr = (const float*)src_lat + (size_t)(row_) * DM; rf[i][0] = *(const f32x4*)(xr + col); rf[i][1] = *(const f32x4*)(xr + col + 4); } } } \
        else { _Pragma("unroll") for (int i = 0; i < 4; ++i) { const int col = (lane + 64 * i) * 8; \
            if constexpr (CB) rb[i] = *(const u32x4*)((const bf16_t*)src_ctx + (size_t)((row_) - ML) * DM + col); \
            else { const float* xr = (const float*)src_ctx + (size_t)((row_) - ML) * DM; rf[i][0] = *(const f32x4*)(xr + col); rf[i][1] = *(const f32x4*)(xr + col + 4); } } } } while (0)
    int row0 = gw;
    if (row0 >= nrows) return;
    int rown = NP_ROWMAP(row0);
    NP_LOAD(rown);
    for (;;) {
        const int row = rown;
        const int s = row < SEQ ? 0 : (row < ML ? 1 : 2);
        f32x4 v[4][2]; float ss = 0.f;
        const bool isb = (row < ML) ? LB : CB;
#pragma unroll
        for (int i = 0; i < 4; ++i) {
            if (isb) { const u32x4 w = rb[i]; v[i][0] = (f32x4){bflo(w.x), bfhi(w.x), bflo(w.y), bfhi(w.y)}; v[i][1] = (f32x4){bflo(w.z), bfhi(w.z), bflo(w.w), bfhi(w.w)}; }
            else { v[i][0] = rf[i][0]; v[i][1] = rf[i][1]; } }
        const int nrow0 = row0 + nw; const bool more = nrow0 < nrows;
        if (more) { rown = NP_ROWMAP(nrow0); NP_LOAD(rown); }
        if (slab != nullptr && row >= ML) {
            f32x4 a[4][2];
#pragma unroll
            for (int i = 0; i < 4; ++i) { a[i][0] = (f32x4){0.f, 0.f, 0.f, 0.f}; a[i][1] = a[i][0]; }
#pragma unroll 4
            for (int ks = 0; ks < nsplit; ++ks) { const float* sp = slab + ((size_t)ks * MC + (row - ML)) * DM;
#pragma unroll
                for (int i = 0; i < 4; ++i) { const int col = (lane + 64 * i) * 8; a[i][0] += *(const f32x4*)(sp + col); a[i][1] += *(const f32x4*)(sp + col + 4); } }
#pragma unroll
            for (int i = 0; i < 4; ++i) { const int col = (lane + 64 * i) * 8;
                v[i][0] += *(const f32x4*)(sgate + col) * a[i][0]; v[i][1] += *(const f32x4*)(sgate + col + 4) * a[i][1];
                u32x4 w = {cvt_pk_bf16(v[i][0][0], v[i][0][1]), cvt_pk_bf16(v[i][0][2], v[i][0][3]), cvt_pk_bf16(v[i][1][0], v[i][1][1]), cvt_pk_bf16(v[i][1][2], v[i][1][3])};
                *(u32x4*)(xout + (size_t)(row - ML) * DM + col) = w;
                v[i][0] = (f32x4){bflo(w.x), bfhi(w.x), bflo(w.y), bfhi(w.y)}; v[i][1] = (f32x4){bflo(w.z), bfhi(w.z), bflo(w.w), bfhi(w.w)}; }
        }
#pragma unroll
        for (int i = 0; i < 4; ++i)
#pragma unroll
            for (int e = 0; e < 4; ++e) ss += v[i][0][e] * v[i][0][e] + v[i][1][e] * v[i][1][e];
        ss = wave_sum(ss);
        const float r = 1.0f / sqrtf(ss * (1.0f / DM) + EPS);
        const float* sh = mod + s * 12288 + jshift * DM; const float* scl = sh + DM;
#pragma unroll
        for (int i = 0; i < 4; ++i) { const int col = (lane + 64 * i) * 8; float y[8];
#pragma unroll
            for (int hh = 0; hh < 2; ++hh) { const f32x4 g = *(const f32x4*)(gain + col + 4 * hh), a = *(const f32x4*)(scl + col + 4 * hh), b = *(const f32x4*)(sh + col + 4 * hh);
#pragma unroll
                for (int e = 0; e < 4; ++e) y[4 * hh + e] = (v[i][hh][e] * r * g[e]) * (1.0f + a[e]) + b[e]; }
            u32x4 w = {cvt_pk_bf16(y[0], y[1]), cvt_pk_bf16(y[2], y[3]), cvt_pk_bf16(y[4], y[5]), cvt_pk_bf16(y[6], y[7])};
            *(u32x4*)(h + (size_t)row * DM + col) = w; }
        if (!more) break;
        row0 = nrow0;
    }
#undef NP_ROWMAP
#undef NP_LOAD
}

__device__ void conv_phase(const bf16_t* p, const float* cw  , bf16_t* acat, int ntok, int wv) {
    const int gt_ = BID() * NT_ + TID(wv), gs_ = GDIM() * NT_;
    for (int id = gt_; id < ntok * 64; id += gs_) {
        const int tok = id >> 6, ch = (id & 63) * 8;
        int t, T; if (tok < ML) { t = tok & (SEQ - 1); T = SEQ; } else { t = (tok - ML) & (CTXL - 1); T = CTXL; }
        const bf16_t* pr = p + (size_t)tok * NINP;
        float y[8];
#pragma unroll
        for (int e = 0; e < 8; ++e) y[e] = 0.f;
#pragma unroll
        for (int d = -1; d <= 1; ++d) {
            if (t + d < 0 || t + d >= T) continue;
            const u32x4 xx = *(const u32x4*)(pr + (long)d * NINP + OFF_CX + ch), cc = *(const u32x4*)(pr + (long)d * NINP + OFF_CC + ch);
            const f32x4 w0 = *(const f32x4*)(cw + (d + 1) * 512 + ch), w1 = *(const f32x4*)(cw + (d + 1) * 512 + ch + 4);
            y[0] += w0[0] * bflo(xx.x) * bflo(cc.x); y[1] += w0[1] * bfhi(xx.x) * bfhi(cc.x);
            y[2] += w0[2] * bflo(xx.y) * bflo(cc.y); y[3] += w0[3] * bfhi(xx.y) * bfhi(cc.y);
            y[4] += w1[0] * bflo(xx.z) * bflo(cc.z); y[5] += w1[1] * bfhi(xx.z) * bfhi(cc.z);
            y[6] += w1[2] * bflo(xx.w) * bflo(cc.w); y[7] += w1[3] * bfhi(xx.w) * bfhi(cc.w);
        }
        const u32x4 bb = *(const u32x4*)(pr + OFF_CB + ch);
        u32x4 w = {cvt_pk_bf16(y[0] * bflo(bb.x), y[1] * bfhi(bb.x)), cvt_pk_bf16(y[2] * bflo(bb.y), y[3] * bfhi(bb.y)),
                   cvt_pk_bf16(y[4] * bflo(bb.z), y[5] * bfhi(bb.z)), cvt_pk_bf16(y[6] * bflo(bb.w), y[7] * bfhi(bb.w))};
        *(u32x4*)(acat + (size_t)tok * DM + 1536 + ch) = w;
    }
}

__device__ __forceinline__ void qkv_prep_phase(const Params& P, int l, int wv) {
    const bf16_t* p = (const bf16_t*)(P.ws + WS_P); const bf16_t* zq = (const bf16_t*)(P.ws + WS_ZQ); const bf16_t* zkv = (const bf16_t*)(P.ws + WS_H);
    bf16_t* Q = (bf16_t*)(P.ws + WS_Q); bf16_t* Qc = (bf16_t*)(P.ws + WS_QC); bf16_t* Kb = (bf16_t*)(P.ws + WS_K); bf16_t* Vb = (bf16_t*)(P.ws + WS_V);
    const float* ROPE = (const float*)(P.ws + WS_ROPE);
    const float* qn = P.in[I_QN] + l * QKH; const float* kn = P.in[I_KN] + l * QKH;
    const int tid = TID(wv), lane = tid & 63, gw = BID() * 8 + (tid >> 6), nw = GDIM() * 8;
    const int h = lane >> 3, s8 = (lane & 7) * 8;
    f32x4 qg[3][2], kg[3][2];
#pragma unroll
    for (int j = 0; j < 3; ++j) { qg[j][0] = *(const f32x4*)(qn + 64 * j + s8); qg[j][1] = *(const f32x4*)(qn + 64 * j + s8 + 4); kg[j][0] = *(const f32x4*)(kn + 64 * j + s8); kg[j][1] = *(const f32x4*)(kn + 64 * j + s8 + 4); }
#define UNPK(W_, f) do { const u32x4 _u = (W_); f[0] = bflo(_u.x); f[1] = bfhi(_u.x); f[2] = bflo(_u.y); f[3] = bfhi(_u.y); f[4] = bflo(_u.z); f[5] = bfhi(_u.z); f[6] = bflo(_u.w); f[7] = bfhi(_u.w); } while (0)
#define PK8(f) (u32x4){cvt_pk_bf16(f[0], f[1]), cvt_pk_bf16(f[2], f[3]), cvt_pk_bf16(f[4], f[5]), cvt_pk_bf16(f[6], f[7])}
    u32x4 n_pa, n_wkr, n_wq[3], n_wk0, n_wk1, n_wv0, n_wv1; u32x2 n_pb; f32x4 n_r[4];
#define QP_LOAD(tok_) do { const bf16_t* pr_ = p + (size_t)(tok_) * NINP; const bool lat_ = (tok_) < ML; const int t_ = lat_ ? ((tok_) & (SEQ - 1)) : 0; \
        const bf16_t* zqr_ = zq + (size_t)(tok_) * 1536 + h * QKH + s8; const bf16_t* zkr_ = zkv + (size_t)(tok_) * 2048 + h * 256 + s8; \
        n_pa = *(const u32x4*)(pr_ + OFF_CQ + lane * 8); n_pb = *(const u32x2*)(pr_ + OFF_CKV + lane * 4); n_wkr = *(const u32x4*)(pr_ + OFF_KR + s8); \
        n_wq[0] = *(const u32x4*)(zqr_); n_wq[1] = *(const u32x4*)(zqr_ + 64); n_wq[2] = *(const u32x4*)(zqr_ + 128);     \
        n_wk0 = *(const u32x4*)(zkr_); n_wk1 = *(const u32x4*)(zkr_ + 64); n_wv0 = *(const u32x4*)(zkr_ + 128); n_wv1 = *(const u32x4*)(zkr_ + 192); \
        const float* rp_ = ROPE + ((size_t)t_ * 32 + (s8 & 31)) * 2; n_r[0] = *(const f32x4*)rp_; n_r[1] = *(const f32x4*)(rp_ + 4); n_r[2] = *(const f32x4*)(rp_ + 8); n_r[3] = *(const f32x4*)(rp_ + 12); } while (0)
    int tokn = gw;
    if (tokn >= MA) return;
    QP_LOAD(tokn);
    for (;;) {
        const int tok = tokn;
        const bool lat = tok < ML;
        int b, t; if (lat) { b = tok >> 12; t = tok & (SEQ - 1); } else { b = (tok - ML) >> 8; t = (tok - ML) & (CTXL - 1); }
        const bool needq = lat || (l == 0);
        const u32x4 pa = n_pa, wkr = n_wkr, wk0 = n_wk0, wk1 = n_wk1, wv0 = n_wv0, wv1 = n_wv1; const u32x2 pb = n_pb;
        u32x4 wq[3] = {n_wq[0], n_wq[1], n_wq[2]};
        const f32x4 r0 = n_r[0], r1 = n_r[1], r2 = n_r[2], r3 = n_r[3];
        const int ntok = tok + nw; const bool more = ntok < MA;
        if (more) QP_LOAD(ntok);
        float cs[8], sn[8];
        if (lat) {
            cs[0] = r0[0]; sn[0] = r0[1]; cs[1] = r0[2]; sn[1] = r0[3]; cs[2] = r1[0]; sn[2] = r1[1]; cs[3] = r1[2]; sn[3] = r1[3];
            cs[4] = r2[0]; sn[4] = r2[1]; cs[5] = r2[2]; sn[5] = r2[3]; cs[6] = r3[0]; sn[6] = r3[1]; cs[7] = r3[2]; sn[7] = r3[3]; }
        else {
#pragma unroll
            for (int e = 0; e < 8; ++e) { cs[e] = 1.f; sn[e] = 0.f; } }
        float fa[8]; UNPK(pa, fa);
        float sq = 0.f;
#pragma unroll
        for (int e = 0; e < 8; ++e) sq += fa[e] * fa[e];
        float skv = bflo(pb.x) * bflo(pb.x) + bfhi(pb.x) * bfhi(pb.x) + bflo(pb.y) * bflo(pb.y) + bfhi(pb.y) * bfhi(pb.y);
        sq = wave_sum(sq); skv = wave_sum(skv);
        const float rq = 1.0f / sqrtf(sq * (1.0f / 512.0f) + EPS), rkv = 1.0f / sqrtf(skv * (1.0f / 256.0f) + EPS);
        const int kpos = lat ? CTXL + t : t;
        const float sgn = (lane & 4) ? 1.f : -1.f;
        if (needq) {
            float e[3][8]; float ss = 0.f;
#pragma unroll
            for (int j = 0; j < 3; ++j) { UNPK(wq[j], e[j]);
#pragma unroll
                for (int i = 0; i < 8; ++i) { e[j][i] *= rq; ss += e[j][i] * e[j][i]; } }
            ss += __shfl_xor(ss, 1); ss += __shfl_xor(ss, 2); ss += __shfl_xor(ss, 4);
            const float rn = 1.0f / sqrtf(ss * (1.0f / QKH) + EPS);
#pragma unroll
            for (int j = 0; j < 3; ++j)
#pragma unroll
                for (int i = 0; i < 8; ++i) e[j][i] *= rn * qg[j][i >> 2][i & 3];
#pragma unroll
            for (int i = 0; i < 8; ++i) { const float part = __shfl_xor(e[2][i], 4); e[2][i] = e[2][i] * cs[i] + sgn * part * sn[i]; }
            bf16_t* qo = (lat ? Q + ((size_t)(b * NH + h) * SEQ + t) * QKH : Qc + ((size_t)(b * NH + h) * CTXL + t) * QKH) + s8;
            *(u32x4*)(qo) = PK8(e[0]); *(u32x4*)(qo + 64) = PK8(e[1]); *(u32x4*)(qo + 128) = PK8(e[2]);
        }
        {
            float k[3][8]; float ss = 0.f; UNPK(wk0, k[0]); UNPK(wk1, k[1]); UNPK(wkr, k[2]);
#pragma unroll
            for (int i = 0; i < 8; ++i) { k[0][i] *= rkv; k[1][i] *= rkv; ss += k[0][i] * k[0][i] + k[1][i] * k[1][i] + k[2][i] * k[2][i]; }
            ss += __shfl_xor(ss, 1); ss += __shfl_xor(ss, 2); ss += __shfl_xor(ss, 4);
            const float rn = 1.0f / sqrtf(ss * (1.0f / QKH) + EPS);
#pragma unroll
            for (int j = 0; j < 3; ++j)
#pragma unroll
                for (int i = 0; i < 8; ++i) k[j][i] *= rn * kg[j][i >> 2][i & 3];
#pragma unroll
            for (int i = 0; i < 8; ++i) { const float part = __shfl_xor(k[2][i], 4); k[2][i] = k[2][i] * cs[i] + sgn * part * sn[i]; }
            bf16_t* ko = Kb + ((size_t)(b * NH + h) * TK + kpos) * QKH + s8;
            *(u32x4*)(ko) = PK8(k[0]); *(u32x4*)(ko + 64) = PK8(k[1]); *(u32x4*)(ko + 128) = PK8(k[2]);
            float v0[8], v1[8]; UNPK(wv0, v0); UNPK(wv1, v1);
#pragma unroll
            for (int i = 0; i < 8; ++i) { v0[i] *= rkv; v1[i] *= rkv; }
            bf16_t* vo = Vb + ((size_t)(b * NH + h) * TK + kpos) * VH + s8;
            *(u32x4*)(vo) = PK8(v0); *(u32x4*)(vo + 64) = PK8(v1);
        }
        if (!more) break;
        tokn = ntok;
    }
#undef QP_LOAD
#undef UNPK
#undef PK8
}

constexpr int LDS_BYTES = g8::STAGE_BYTES;
static_assert(at::SHM_ATTN2 <= (size_t)LDS_BYTES && 4 * 64 * 65 * 4 <= LDS_BYTES, "LDS budget");
constexpr int N_PHASES = 1 + 2 * 10;

template <int PH>
__device__ __forceinline__ void run_phase(const Params& P0, LAS unsigned char* lds, unsigned char* lds_raw, int wv) {
    size_t z = 0; asm volatile("" : "+s"(z));
    const int G = GDIM(), bid = BID();
    Params P;
#pragma unroll
    for (int i = 0; i < 24; ++i) P.in[i] = P0.in[i] + z;
    P.out = P0.out + z; P.ws = P0.ws + z; P.ph_lo = 0; P.ph_hi = 0;
    unsigned char* ws = P.ws;
    bf16_t* Hb = (bf16_t*)(ws + WS_H); bf16_t* Pb = (bf16_t*)(ws + WS_P); bf16_t* ZQ = (bf16_t*)(ws + WS_ZQ);
    bf16_t* ACAT = (bf16_t*)(ws + WS_ACAT); bf16_t* XA = (bf16_t*)(ws + WS_XA); float* modall = (float*)(ws + WS_MOD);
    constexpr int ph = PH;
    {
        if (ph == 0) { PHON(10) { adaln_phase(P, wv); dft_phase(P, wv); wprep_phase(P, 0, lds_raw, wv); } return; }
        constexpr int l = (ph - 1) / 10, sp = (ph - 1) % 10;
        const float* mod = modall + (size_t)l * 3 * 12288;
        constexpr int nMl = (l == 0) ? 34 : 32;
        bf16_t* XAc = XA + (size_t)ML * DM;
        switch (sp) {
        case 0: PHON(0) {
            if (l == 1) wprep_phase(P, 1, lds_raw, wv);
            if (l == 0) norm_phase<false, false>(P.in[I_X], P.in[I_CTX], MA, P.in[I_NMIX] + l * DM, mod, 0, Hb, wv);
            else norm_phase<true, true>(XA, XAc, MA, P.in[I_NMIX] + l * DM, mod, 0, Hb, wv, (const float*)(ws + WS_SLAB), 11, modall + 2 * 12288 + 5 * DM, XAc);
        } break;
        case 1: PHON(1) {
            g8::Gemm g{Hb, (const bf16_t*)(ws + WS_WIN), DM, DM, DM}; g8::Order S;
            if (l == 0) S.init(34, 36, G, bid); else S.init(32, 36, G, bid, 32, 4, 2, 2);
            g8::EpiBf16 E{Pb, NINP, 0, 0, 0, (const float*)(ws + WS_BIAS)};
            g8::gemm_phase<g8::EpiBf16>(lds, g, S, E, wv);
        } break;
        case 2: PHON(2) {
            { g8::Gemm g{Pb + OFF_CQ, (const bf16_t*)(ws + WS_WUQ), NINP, 512, 512}; g8::Order S; S.init(nMl, 6, G, bid);
              g8::EpiBf16 E{ZQ, 1536, 0, 0, 0, nullptr}; g8::gemm_phase<g8::EpiBf16>(lds, g, S, E, wv); }
            { g8::Gemm g{Pb + OFF_CKV, (const bf16_t*)(ws + WS_WUKV), NINP, 256, 256}; g8::Order S; S.init(34, 8, G, (bid + 64) % G);
              g8::EpiBf16 E{Hb, 2048, 0, 0, 0, nullptr}; g8::gemm_phase<g8::EpiBf16>(lds, g, S, E, wv); }
            { g8::Gemm g{(const bf16_t*)(ws + WS_BD), Pb + OFF_F, 512, NINP, 512}; g8::Order S; S.init(4, 32, G, (bid + G - 16) % G);
              g8::EpiF1 E{(bf16_t*)(ws + WS_GT), (bf16_t*)(ws + WS_GTC), 0}; g8::gemm_phase<g8::EpiF1, 1>(lds, g, S, E, wv); }
            if (l == 0) { g8::Gemm g{(const bf16_t*)(ws + WS_BD), Pb + (size_t)ML * NINP + OFF_F, 512, NINP, 512}; g8::Order S; S.init(4, 2, G, (bid + G - 144) % G);
              g8::EpiF1 E{(bf16_t*)(ws + WS_GT), (bf16_t*)(ws + WS_GTC), 32}; g8::gemm_phase<g8::EpiF1, 0>(lds, g, S, E, wv); }
            conv_phase(Pb, P.in[I_CONVW] + l * 3 * 512, ACAT, nMl * 256, wv);
        } break;
        case 3: PHON(3) {
            qkv_prep_phase(P, l, wv);
            __syncthreads();
            { g8::Gemm g{(const bf16_t*)(ws + WS_DB), (const bf16_t*)(ws + WS_GT), 128, 64, 128, 128, 8192}; g8::Order S; S.init(1, 256, G, bid);
              g8::EpiTw E{(bf16_t*)(ws + WS_VP), (const float*)(ws + WS_TW)}; g8::gemm_phase<g8::EpiTw, 2>(lds, g, S, E, wv); }
        } break;
        case 4: PHON(4) {
            const bf16_t* Q = (const bf16_t*)(ws + WS_Q); const bf16_t* Qc = (const bf16_t*)(ws + WS_QC);
            const bf16_t* Kb = (const bf16_t*)(ws + WS_K); const bf16_t* Vb = (const bf16_t*)(ws + WS_V);
            for (int it = bid; it < 256; it += G) {
                const int xcd = it & 7, slot = it >> 3, bh = xcd * 2 + (slot >> 4), qb = slot & 15, b = bh >> 3, h = bh & 7;
                at::attn_body(Q + ((size_t)bh * SEQ + qb * 256) * QKH, Kb + (size_t)bh * TK * QKH, Vb + (size_t)bh * TK * VH,
                              ACAT + (size_t)(b * SEQ + qb * 256) * DM + 512 + h * VH, DM, TK, (char*)lds_raw, wv);
                __syncthreads();
            }
#ifndef X_NOCTXATT
            if (l == 0) for (int it = bid; it < 16; it += G) {
                const int bh = it, b = bh >> 3, h = bh & 7;
                at::attn_body(Qc + (size_t)bh * CTXL * QKH, Kb + (size_t)bh * TK * QKH, Vb + (size_t)bh * TK * VH,
                              ACAT + (size_t)(ML + b * CTXL) * DM + 512 + h * VH, DM, CTXL, (char*)lds_raw, wv);
                __syncthreads();
            }
#endif
#ifndef X_NOF2
            { g8::Gemm g{(const bf16_t*)(ws + WS_DC), (const bf16_t*)(ws + WS_VP), 128, 128, 128}; g8::Order S; S.init(1, 256, G, bid);
              g8::EpiFm2 E{ACAT}; g8::gemm_phase<g8::EpiFm2>(lds, g, S, E, wv); }
            if (l == 0) { g8::Gemm g{(const bf16_t*)(ws + WS_A2C), (const bf16_t*)(ws + WS_GTC), 512, 512, 512}; g8::Order S; S.init(1, 4, 4, (bid >= 16 && bid < 20) ? bid - 16 : -1);
              g8::EpiBf16 E{ACAT, DM, 2, (size_t)CTXL * DM, ML, nullptr}; g8::gemm_phase<g8::EpiBf16>(lds, g, S, E, wv); }
#endif
        } break;
        case 5: PHON(5) {
            g8::Gemm g{ACAT, (const bf16_t*)(ws + WS_WMG), DM, DM, DM}; g8::Order S;
            if (l == 0) S.init(32, 8, G, bid, 32, 0, 2, 8, 4, 512); else S.init(32, 8, G, bid);
            g8::EpiMerge E{Pb, Hb, (float*)(ws + WS_SLAB), (unsigned*)(ws + WS_CNT)}; g8::gemm_phase<g8::EpiMerge>(lds, g, S, E, wv);
        } break;
        case 6: PHON(6) {
            g8::Gemm g{Hb, (const bf16_t*)(ws + WS_WOUT), DM, DM, DM}; g8::Order S;
            if (l == 0) S.init(32, 8, G, bid, 32, 0, 2, 8, 8, 256); else S.init(32, 8, G, bid);
            if (l == 0) { g8::EpiResid<false, true> E{P.in[I_X], P.in[I_CTX], XA, XAc, mod + 2 * DM, (float*)(ws + WS_SLAB)}; g8::gemm_phase<g8::EpiResid<false, true>>(lds, g, S, E, wv); }
            else { g8::EpiResid<true, true> E{XA, XAc, XA, XAc, mod + 2 * DM, (float*)(ws + WS_SLAB)}; g8::gemm_phase<g8::EpiResid<true, true>>(lds, g, S, E, wv); }
        } break;
        case 7: PHON(7) {
            if (l == 0) norm_phase<true, false>(XA, P.in[I_CTX], MA, P.in[I_NFFN] + l * DM, mod, 3, Hb, wv, (const float*)(ws + WS_SLAB), 8, mod + 2 * 12288 + 2 * DM, XAc);
            else norm_phase<true, true>(XA, XAc, nMl * 256, P.in[I_NFFN] + l * DM, mod, 3, Hb, wv);
        } break;
        case 8: PHON(8) {
            g8::Gemm g{Hb, (const bf16_t*)(ws + WS_WGU), DM, DM, DM}; g8::Order S; S.init(nMl, 44, G, bid);
            g8::EpiSwiglu E{Pb}; g8::gemm_phase<g8::EpiSwiglu>(lds, g, S, E, wv);
        } break;
        default: PHON(9) {
            g8::Gemm g{Pb, (const bf16_t*)(ws + WS_WD), DFF, DFF, DFF}; g8::Order S;
            if (l == 0) S.init(32, 8, G, bid, 32, 0, 2, 8, 11, 512); else S.init(32, 8, G, bid);
            if (l == 0) { g8::EpiResid<true, true> E{XA, XAc, XA, XAc, mod + 5 * DM, (float*)(ws + WS_SLAB)}; g8::gemm_phase<g8::EpiResid<true, true>>(lds, g, S, E, wv); }
            else { g8::EpiResid<true, false> E{XA, XAc, P.out, P.out, mod + 5 * DM, (float*)(ws + WS_SLAB)}; g8::gemm_phase<g8::EpiResid<true, false>>(lds, g, S, E, wv); }
        } break;
        }

    }
}

__global__ void __launch_bounds__(512, 2) mk_fwd(Params P0) {
    extern __shared__ __attribute__((aligned(16))) unsigned char lds_raw[];
    LAS unsigned char* lds = (LAS unsigned char*)lds_raw;
    const int lo = P0.ph_lo, hi = P0.ph_hi;
    const int wv = __builtin_amdgcn_readfirstlane((int)threadIdx.x >> 6);
    unsigned* barw = (unsigned*)(P0.ws + WS_XBAR);
    if (hi < 0) cg::this_grid().sync();
    XBar xb; xb.w = barw; xb.xcc = 0; xb.nx = 0; xb.nxcc = 0;
    if (lo == 0) xbar_post(barw, wv);
    unsigned nbar = 0;
#ifndef MK_REPEAT_MASK
#define MK_REPEAT_MASK 0u
#endif
#define RUN(k) if (lo <= (k) && (k) < hi) { if ((k) > lo) { if ((k) == 1) { grid_barrier_first((unsigned*)(P0.ws + WS_BAR), gridDim.x, wv); xb = xbar_setup(barw); } else grid_barrier(xb, ++nbar, wv); } run_phase<(k)>(P0, lds, lds_raw, wv); \
        if constexpr ((MK_REPEAT_MASK >> (k)) & 1u) { grid_barrier(xb, ++nbar, wv); run_phase<(k)>(P0, lds, lds_raw, wv); } }
    RUN(0) RUN(1) RUN(2) RUN(3) RUN(4) RUN(5) RUN(6) RUN(7) RUN(8) RUN(9) RUN(10)
    RUN(11) RUN(12) RUN(13) RUN(14) RUN(15) RUN(16) RUN(17) RUN(18) RUN(19) RUN(20)
#undef RUN
}

extern "C" void kernel_launch(void* const* d_in, const int* in_sizes, int n_in, void* d_out, int out_size, void* d_ws, size_t ws_size, hipStream_t stream) {
    static int grid = 0;
    if (grid == 0) {
        if (n_in != 24 || out_size != ML * DM || ws_size < WS_END) { fprintf(stderr, "kernel_launch: unexpected shapes (n_in %d out %d ws %zu need %zu)\n", n_in, out_size, ws_size, (size_t)WS_END); grid = -1; return; }
        int dev = 0, cus = 0, per_cu = 0;
        hipGetDevice(&dev); hipDeviceGetAttribute(&cus, hipDeviceAttributeMultiprocessorCount, dev);
        if (hipFuncSetAttribute((const void*)mk_fwd, hipFuncAttributeMaxDynamicSharedMemorySize, LDS_BYTES) != hipSuccess) { fprintf(stderr, "kernel_launch: hipFuncSetAttribute failed\n"); grid = -1; return; }
        if (hipOccupancyMaxActiveBlocksPerMultiprocessor(&per_cu, (const void*)mk_fwd, 512, LDS_BYTES) != hipSuccess || per_cu < 1) { fprintf(stderr, "kernel_launch: occupancy query says %d\n", per_cu); per_cu = 1; }
        (void)hipGetLastError();
        grid = cus * 1;
    }
    if (grid < 0) return;
    hipMemsetAsync((char*)d_ws + WS_MOD, 0, WS_ZERO_BYTES, stream);
    Params p{};
    for (int i = 0; i < 24; ++i) p.in[i] = (const float*)d_in[i];
    p.out = (float*)d_out; p.ws = (unsigned char*)d_ws;
#if MK_PER_PHASE
    for (int ph = 0; ph < N_PHASES; ++ph) { p.ph_lo = ph; p.ph_hi = ph + 1; hipLaunchKernelGGL(mk_fwd, dim3(grid), dim3(512), LDS_BYTES, stream, p); }
#else
    p.ph_lo = 0; p.ph_hi = N_PHASES;
    void* args[] = {&p};
    hipError_t e = hipLaunchCooperativeKernel((const void*)mk_fwd, dim3(grid), dim3(512), args, LDS_BYTES, stream);
    if (e != hipSuccess) fprintf(stderr, "kernel_launch: cooperative launch failed: %s (grid %d)\n", hipGetErrorString(e), grid);
#endif
}
```
